# Optimizing an MI355X kernel written in HIP

```python
import math
import jax
import jax.numpy as jnp
from jax import lax
import numpy as np

D_MODEL = 1024
BATCH = 8
SEQ = 4096
DEPTH = 4

N_MIXERS = 3
N_LAYERS_A = (DEPTH + 2) // 3
N_LAYERS_B = (DEPTH + 1) // 3
N_LAYERS_C = DEPTH // 3

HEAD_DIM = 64
ROT_DIM = HEAD_DIM // 4
ROPE_THETA = 500000.0
NORM_EPS = 1e-6
NEG_INF = -1e30
Q_BLOCK = 128

DIFF_HEADS = D_MODEL // (2 * HEAD_DIM)
DIFF_QK_WIDTH = DIFF_HEADS * 2 * HEAD_DIM
DIFF_V_DIM = 2 * HEAD_DIM
DIFF_SUBLN_EPS = 1e-5

MOBA_HEADS = D_MODEL // HEAD_DIM
MOBA_BLOCK = 256
MOBA_TOPK = 3

NSA_HEADS = D_MODEL // HEAD_DIM
NSA_GROUPS = NSA_HEADS // 4
NSA_REP = NSA_HEADS // NSA_GROUPS
NSA_Q_BLOCK = 64
CMP_LEN = 32
CMP_STRIDE = 16
CMP_HIDDEN = 4 * HEAD_DIM
SLC_BLOCK = 64
SLC_TOPK = 16
WINDOW = 512
FORCED_SCORE = 1e9
NSA_KV_WIDTH = NSA_GROUPS * HEAD_DIM
NSA_IN_WIDTH = NSA_HEADS * HEAD_DIM + 6 * NSA_KV_WIDTH + 3 * NSA_HEADS

D_FF = 2816

kernel_name = "hybrid_diff_moba_nsa_macaron_trunk"


def rms_norm(x, g, eps=NORM_EPS):
    xf = x.astype(jnp.float32)
    y = xf * lax.rsqrt(jnp.mean(xf * xf, axis=-1, keepdims=True) + eps)
    return (y * g.astype(jnp.float32)).astype(x.dtype)


def partial_rope(x, pos):
    half = ROT_DIM // 2
    inv_freq = ROPE_THETA ** (-jnp.arange(half, dtype=jnp.float32) / half)
    ang = pos.astype(jnp.float32)[:, None] * inv_freq[None, :]
    cos = jnp.cos(ang)[None, :, None, :].astype(x.dtype)
    sin = jnp.sin(ang)[None, :, None, :].astype(x.dtype)
    x1, x2, rest = x[..., :half], x[..., half:ROT_DIM], x[..., ROT_DIM:]
    return jnp.concatenate([x1 * cos - x2 * sin, x2 * cos + x1 * sin, rest], axis=-1)


def masked_probs(scores, mask):
    p = jax.nn.softmax(jnp.where(mask, scores, NEG_INF), axis=-1)
    return jnp.where(mask, p, 0.0)


def gather_blocks(blocks, idx):
    return jax.vmap(jax.vmap(lambda bl, ix: bl[ix]))(blocks, idx)


def chunked(fn, n_chunks):
    o = jnp.moveaxis(lax.map(fn, jnp.arange(n_chunks)), 0, 1)
    return o.reshape((o.shape[0], o.shape[1] * o.shape[2]) + o.shape[3:])


def swiglu(x, w_in, w_out):
    gate, up = jnp.split(x @ w_in, 2, axis=-1)
    return (jax.nn.silu(gate) * up) @ w_out


def diff_attention(h, w_in, w_out, lam, subln_g, lambda_init, pos):
    B, S, _ = h.shape
    H, Dh = DIFF_HEADS, HEAD_DIM
    q, k, v = jnp.split(h @ w_in, 3, axis=-1)
    q = partial_rope(q.reshape(B, S, 2 * H, Dh), pos).reshape(B, S, H, 2, Dh)
    k = partial_rope(k.reshape(B, S, 2 * H, Dh), pos).reshape(B, S, H, 2, Dh)
    v = v.reshape(B, S, H, DIFF_V_DIM)
    lam = lam.astype(jnp.float32)
    lam_full = jnp.exp(jnp.sum(lam[0] * lam[1])) - jnp.exp(jnp.sum(lam[2] * lam[3])) + lambda_init
    scale = Dh ** -0.5

    def chunk(i):
        s0 = i * Q_BLOCK
        qc = lax.dynamic_slice_in_dim(q, s0, Q_BLOCK, axis=1)
        qpos = lax.dynamic_slice_in_dim(pos, s0, Q_BLOCK)
        sc = jnp.einsum('bqhcd,bkhcd->bhcqk', qc, k, preferred_element_type=jnp.float32) * scale
        p = masked_probs(sc, pos[None, :] <= qpos[:, None])
        a = p[:, :, 0] - lam_full * p[:, :, 1]
        return jnp.einsum('bhqk,bkhe->bqhe', a.astype(v.dtype), v)

    o = chunked(chunk, S // Q_BLOCK)
    o = rms_norm(o, subln_g, DIFF_SUBLN_EPS) * (1.0 - lambda_init)
    return o.reshape(B, S, H * DIFF_V_DIM) @ w_out


def moba_attention(h, w_in, w_out, pos):
    B, S, _ = h.shape
    H, Dh, L = MOBA_HEADS, HEAD_DIM, MOBA_BLOCK
    q, k, v = jnp.split(h @ w_in, 3, axis=-1)
    q = partial_rope(q.reshape(B, S, H, Dh), pos)
    k = partial_rope(k.reshape(B, S, H, Dh), pos)
    v = v.reshape(B, S, H, Dh)
    nb = -(-S // L)
    pad = nb * L - S

    def to_blocks(t):
        t = jnp.pad(t, ((0, 0), (0, pad), (0, 0), (0, 0)))
        return t.reshape(B, nb, L, H, Dh).transpose(0, 3, 1, 2, 4)

    kb, vb = to_blocks(k), to_blocks(v)
    k_mean = jnp.mean(kb.astype(jnp.float32), axis=3)
    topk = min(MOBA_TOPK, nb)
    blk_ids = jnp.arange(nb)
    scale = Dh ** -0.5

    def chunk(i):
        s0 = i * Q_BLOCK
        qidx = s0 + jnp.arange(Q_BLOCK)
        cur = s0 // L
        qc = lax.dynamic_slice_in_dim(q, s0, Q_BLOCK, axis=1)
        gate = jnp.einsum('bqhd,bhnd->bhqn', qc.astype(jnp.float32), k_mean)
        gate = jnp.where(blk_ids < cur, gate, NEG_INF)
        top_s, top_i = lax.top_k(gate, topk)
        sel_mask = jnp.broadcast_to((top_s > 0.5 * NEG_INF)[..., None],
                                    top_s.shape + (L,)).reshape(B, H, Q_BLOCK, topk * L)
        ksel = gather_blocks(kb, top_i).reshape(B, H, Q_BLOCK, topk * L, Dh)
        vsel = gather_blocks(vb, top_i).reshape(B, H, Q_BLOCK, topk * L, Dh)
        kown = lax.dynamic_index_in_dim(kb, cur, axis=2, keepdims=False)
        vown = lax.dynamic_index_in_dim(vb, cur, axis=2, keepdims=False)
        own_mask = jnp.broadcast_to((cur * L + jnp.arange(L))[None, :] <= qidx[:, None],
                                    (B, H, Q_BLOCK, L))
        s_sel = jnp.einsum('bqhd,bhqkd->bhqk', qc, ksel, preferred_element_type=jnp.float32)
        s_own = jnp.einsum('bqhd,bhkd->bhqk', qc, kown, preferred_element_type=jnp.float32)
        scores = jnp.concatenate([s_sel, s_own], axis=-1) * scale
        p = masked_probs(scores, jnp.concatenate([sel_mask, own_mask], axis=-1)).astype(v.dtype)
        return (jnp.einsum('bhqk,bhqkd->bqhd', p[..., :topk * L], vsel)
                + jnp.einsum('bhqk,bhkd->bqhd', p[..., topk * L:], vown))

    o = chunked(chunk, S // Q_BLOCK)
    return o.reshape(B, S, H * Dh) @ w_out


def compress(t, pe, w1, w2):
    B, S, G, Dh = t.shape
    r = CMP_LEN // CMP_STRIDE
    c = t.reshape(B, S // CMP_STRIDE, CMP_STRIDE, G, Dh)
    nc = S // CMP_STRIDE - r + 1
    blocks = jnp.concatenate([c[:, j:j + nc] for j in range(r)], axis=2)
    blocks = blocks + pe[None, None, :, None, :].astype(t.dtype)
    flat = blocks.transpose(0, 1, 3, 2, 4).reshape(B, nc, G, CMP_LEN * Dh)
    return jax.nn.silu(flat @ w1) @ w2


def nsa_attention(h, w_in, w_out, cmp_pe, cmp_w1, cmp_w2, pos):
    B, S, _ = h.shape
    H, G, R, Dh = NSA_HEADS, NSA_GROUPS, NSA_REP, HEAD_DIM
    Qb = NSA_Q_BLOCK
    splits = [H * Dh + j * NSA_KV_WIDTH for j in range(7)]
    q, kc, vc, ks, vs, kw, vw, g_logits = jnp.split(h @ w_in, splits, axis=-1)
    q = partial_rope(q.reshape(B, S, H, Dh), pos).reshape(B, S, G, R, Dh)

    def kv(t):
        return t.reshape(B, S, G, Dh)

    kcmp = compress(partial_rope(kv(kc), pos), cmp_pe[0], cmp_w1[0], cmp_w2[0])
    vcmp = compress(kv(vc), cmp_pe[1], cmp_w1[1], cmp_w2[1])
    nc = kcmp.shape[1]
    cmp_end = jnp.arange(nc) * CMP_STRIDE + CMP_LEN - 1
    nsel = S // SLC_BLOCK
    n_top = min(SLC_TOPK, nsel)
    cmp_start = jnp.arange(nc)[:, None] * CMP_STRIDE
    blk_start = jnp.arange(nsel)[None, :] * SLC_BLOCK
    overlap = ((cmp_start < blk_start + SLC_BLOCK) & (cmp_start + CMP_LEN > blk_start)).astype(jnp.float32)

    def sel_blocks(t):
        return t.reshape(B, nsel, SLC_BLOCK, G, Dh).transpose(0, 3, 1, 2, 4)

    kb = sel_blocks(partial_rope(kv(ks), pos))
    vb = sel_blocks(kv(vs))
    def padw(t):
        return jnp.pad(t, ((0, 0), (WINDOW, 0), (0, 0), (0, 0)))

    kwp = padw(partial_rope(kv(kw), pos))
    vwp = padw(kv(vw))
    gates = jax.nn.sigmoid(g_logits).reshape(B, S, G, R, 3)
    blk_ids = jnp.arange(nsel)
    scale = Dh ** -0.5

    def chunk(i):
        s0 = i * Qb
        qidx = s0 + jnp.arange(Qb)
        qc = lax.dynamic_slice_in_dim(q, s0, Qb, axis=1)
        s_c = jnp.einsum('bqgrd,bngd->bgrqn', qc, kcmp, preferred_element_type=jnp.float32) * scale
        p_c = masked_probs(s_c, cmp_end[None, :] <= qidx[:, None])
        o_c = jnp.einsum('bgrqn,bngd->bqgrd', p_c.astype(vcmp.dtype), vcmp)
        imp = jnp.einsum('bgrqn,nj->bgqj', p_c, overlap)
        qblk = (qidx // SLC_BLOCK)[:, None]
        forced = (blk_ids == 0) | (blk_ids == qblk) | (blk_ids == qblk - 1)
        imp = jnp.where(blk_ids <= qblk, jnp.where(forced, FORCED_SCORE, imp), NEG_INF)
        top_s, top_i = lax.top_k(imp, n_top)
        kidx = top_i[..., None] * SLC_BLOCK + jnp.arange(SLC_BLOCK)
        m_s = ((top_s > 0.5 * NEG_INF)[..., None] & (kidx <= qidx[:, None, None])
               ).reshape(B, G, 1, Qb, n_top * SLC_BLOCK)
        ksel = gather_blocks(kb, top_i).reshape(B, G, Qb, n_top * SLC_BLOCK, Dh)
        vsel = gather_blocks(vb, top_i).reshape(B, G, Qb, n_top * SLC_BLOCK, Dh)
        s_s = jnp.einsum('bqgrd,bgqkd->bgrqk', qc, ksel, preferred_element_type=jnp.float32) * scale
        p_s = masked_probs(s_s, m_s)
        o_s = jnp.einsum('bgrqk,bgqkd->bqgrd', p_s.astype(vsel.dtype), vsel)
        kwc = lax.dynamic_slice_in_dim(kwp, s0, WINDOW + Qb, axis=1)
        vwc = lax.dynamic_slice_in_dim(vwp, s0, WINDOW + Qb, axis=1)
        kidx_w = s0 - WINDOW + jnp.arange(WINDOW + Qb)
        dist = qidx[:, None] - kidx_w[None, :]
        m_w = (kidx_w[None, :] >= 0) & (dist >= 0) & (dist < WINDOW)
        s_w = jnp.einsum('bqgrd,bkgd->bgrqk', qc, kwc, preferred_element_type=jnp.float32) * scale
        p_w = masked_probs(s_w, m_w)
        o_w = jnp.einsum('bgrqk,bkgd->bqgrd', p_w.astype(vwc.dtype), vwc)
        gc = lax.dynamic_slice_in_dim(gates, s0, Qb, axis=1)
        return gc[..., 0:1] * o_c + gc[..., 1:2] * o_s + gc[..., 2:3] * o_w

    o = chunked(chunk, S // Qb)
    return o.reshape(B, S, H * Dh) @ w_out


def setup_inputs(seed: int = 0) -> dict:
    key = jax.random.key(seed)
    ks = jax.random.split(key, 15)

    def nrm(k, shape):
        return jax.random.normal(k, shape, jnp.float32)

    def w(k, shape, fan_in):
        return nrm(k, shape) * fan_in ** -0.5

    return {
        "x": nrm(ks[0], (BATCH, SEQ, D_MODEL)),
        "norm_g": 1.0 + 0.05 * nrm(ks[1], (DEPTH, 6, D_MODEL)),
        "ffn_w_in": w(ks[2], (DEPTH, 2, D_MODEL, 2 * D_FF), D_MODEL),
        "ffn_w_out": w(ks[3], (DEPTH, 2, D_FF, D_MODEL), D_FF),
        "diff_w_in": w(ks[4], (N_LAYERS_A, D_MODEL, 3 * DIFF_QK_WIDTH), D_MODEL),
        "diff_w_out": w(ks[5], (N_LAYERS_A, DIFF_HEADS * DIFF_V_DIM, D_MODEL), DIFF_HEADS * DIFF_V_DIM),
        "diff_lambda": 0.1 * nrm(ks[6], (N_LAYERS_A, 4, HEAD_DIM)),
        "diff_subln": 1.0 + 0.05 * nrm(ks[7], (N_LAYERS_A, DIFF_V_DIM)),
        "moba_w_in": w(ks[8], (N_LAYERS_B, D_MODEL, 3 * MOBA_HEADS * HEAD_DIM), D_MODEL),
        "moba_w_out": w(ks[9], (N_LAYERS_B, MOBA_HEADS * HEAD_DIM, D_MODEL), MOBA_HEADS * HEAD_DIM),
        "nsa_w_in": w(ks[10], (N_LAYERS_C, D_MODEL, NSA_IN_WIDTH), D_MODEL),
        "nsa_w_out": w(ks[11], (N_LAYERS_C, NSA_HEADS * HEAD_DIM, D_MODEL), NSA_HEADS * HEAD_DIM),
        "nsa_cmp_pe": 0.2 * nrm(ks[12], (N_LAYERS_C, 2, CMP_LEN, HEAD_DIM)),
        "nsa_cmp_w1": w(ks[13], (N_LAYERS_C, 2, CMP_LEN * HEAD_DIM, CMP_HIDDEN), CMP_LEN * HEAD_DIM),
        "nsa_cmp_w2": w(ks[14], (N_LAYERS_C, 2, CMP_HIDDEN, HEAD_DIM), CMP_HIDDEN),
    }


def reference(x, norm_g, ffn_w_in, ffn_w_out, diff_w_in, diff_w_out, diff_lambda, diff_subln,
              moba_w_in, moba_w_out, nsa_w_in, nsa_w_out, nsa_cmp_pe, nsa_cmp_w1, nsa_cmp_w2):
    pos = jnp.arange(x.shape[1])
    h = x
    for i in range(DEPTH):
        g = norm_g[i]
        h = h + 0.5 * rms_norm(swiglu(rms_norm(h, g[0]), ffn_w_in[i, 0], ffn_w_out[i, 0]), g[1])
        m = rms_norm(h, g[2])
        kind, j = i % N_MIXERS, i // N_MIXERS
        if kind == 0:
            lambda_init = 0.8 - 0.6 * math.exp(-0.3 * i)
            m = diff_attention(m, diff_w_in[j], diff_w_out[j], diff_lambda[j], diff_subln[j],
                               lambda_init, pos)
        elif kind == 1:
            m = moba_attention(m, moba_w_in[j], moba_w_out[j], pos)
        else:
            m = nsa_attention(m, nsa_w_in[j], nsa_w_out[j], nsa_cmp_pe[j], nsa_cmp_w1[j],
                              nsa_cmp_w2[j], pos)
        h = h + rms_norm(m, g[3])
        h = h + 0.5 * rms_norm(swiglu(rms_norm(h, g[4]), ffn_w_in[i, 1], ffn_w_out[i, 1]), g[5])
    return h
```

```cpp
#include <hip/hip_runtime.h>
#include <cstdio>
#include <cstdint>
#define DIFF_FAST 1
#define MOBA_FAST 1
#define NSA_FAST 1
#if DIFF_FAST
#define DIFF_ATTN diff_attn_pipe
#else
#define DIFF_ATTN diff_attn_slow
#endif
#if MOBA_FAST
#define MOBA_ATTN moba_attn_fast2
#else
#define MOBA_ATTN moba_attn_slow
#endif

namespace pg8 {
#define PG8_LAS __attribute__((address_space(3)))
typedef unsigned short bf16_t;
typedef short bf16x8 __attribute__((ext_vector_type(8)));
typedef float f32x4 __attribute__((ext_vector_type(4)));
typedef unsigned u32x4 __attribute__((ext_vector_type(4)));
typedef int i32x4 __attribute__((ext_vector_type(4)));
typedef int i32x8 __attribute__((ext_vector_type(8)));
typedef unsigned u32x2 __attribute__((ext_vector_type(2)));
constexpr int BM = 256, BK = 64, HALF = 128, HTB = HALF * BK * 2  , STAGE_BYTES = 8 * HTB, NXCD = 8, WGM = 8;

__host__ __device__ __forceinline__ int lds_byte(int r, int c) { const int st = (r >> 4) * 2 + (c >> 5), rr = r & 15, cc = c & 31, ob = rr * 64 + cc * 2; return st * 1024 + (ob ^ (((ob >> 9) & 1) << 5)); }
__host__ __device__ __forceinline__ void stage_rc(int b, int& R, int& C) { const int st = b / 1024, sb = b % 1024, swz = sb ^ (((sb >> 9) & 1) << 5); R = (st >> 1) * 16 + swz / 64; C = (st & 1) * 32 + (swz % 64) / 2; }
__host__ __device__ __forceinline__ int perm32(int rho) { const int n = rho >> 4, i = rho & 15; return 8 * (i >> 2) + 4 * n + (i & 3); }

struct Unit { int pm, pn; };
struct Gemm { const bf16_t* A; const bf16_t* Bt; int lda, K; };

struct StaticOrder {
    int nM, nN, nwg, G, c;
    __host__ __device__ void init(int M, int N, int G_, int c_) { nM = M / BM; nN = N / BM; nwg = nM * nN; G = G_; c = c_; }
    __host__ __device__ bool next(int i, Unit& u) const {
        const long L = (long)i * G + c; if (L >= nwg) return false;
        int wgid = (int)L; { const int q = nwg / NXCD, r = nwg % NXCD, xcd = wgid % NXCD, off = wgid / NXCD; wgid = (xcd < r ? xcd * (q + 1) : r * (q + 1) + (xcd - r) * q) + off; }
        const int nig = WGM * nN, gid = wgid / nig, fm = gid * WGM, gsz = (nM - fm) < WGM ? (nM - fm) : WGM;
        u.pm = fm + ((wgid % nig) % gsz); u.pn = (wgid % nig) / gsz; return true;
    }
    __device__ __forceinline__ void a_ready(const Unit&) const {}
    __device__ __forceinline__ void done(const Unit&) const {}
};
struct CmpOrder {
    int G, c;
    __device__ bool next(int i, Unit& u) const { const int L = i * G + c; if (L >= 64) return false; u.pm = L; u.pn = L >> 5; return true; }
    __device__ __forceinline__ void a_ready(const Unit&) const {}
    __device__ __forceinline__ void done(const Unit&) const {}
};

struct TileOrder {
    int G, c, pn;
    __device__ bool next(int i, Unit& u) const { if (c < 0) return false; const int L = i * G + c; if (L >= 128) return false; u.pm = L; u.pn = pn; return true; }
    __device__ __forceinline__ void a_ready(const Unit&) const {}
    __device__ __forceinline__ void done(const Unit&) const {}
};
__device__ __forceinline__ unsigned cvt_pk_bf16(float lo, float hi) { unsigned r; asm volatile("v_cvt_pk_bf16_f32 %0, %1, %2" : "=v"(r) : "v"(lo), "v"(hi)); return r; }
__device__ __forceinline__ u32x4 pack8(const f32x4 v0, const f32x4 v1) { u32x4 w; w.x = cvt_pk_bf16(v0[0], v0[1]); w.y = cvt_pk_bf16(v0[2], v0[3]); w.z = cvt_pk_bf16(v1[0], v1[1]); w.w = cvt_pk_bf16(v1[2], v1[3]); return w; }
__device__ __forceinline__ float sigmoid_f(float x) { return __builtin_amdgcn_rcpf(1.0f + __builtin_amdgcn_exp2f(-1.4426950408889634f * x)); }
__device__ __forceinline__ f32x4 silu4(const f32x4 x) { f32x4 r; r[0] = x[0] * sigmoid_f(x[0]); r[1] = x[1] * sigmoid_f(x[1]); r[2] = x[2] * sigmoid_f(x[2]); r[3] = x[3] * sigmoid_f(x[3]); return r; }

struct EpiPlain {
    static constexpr bool PERM = true, AFTER_DRAIN = false, HAS_PRE = false;
    bf16_t* O; int ldc; const float* oscp;
    __device__ __forceinline__ void operator()(const f32x4 (&acc)[2][2][4][2], const Unit& u, int wr, int wc, int fr, int fq) const {
        const int row0 = u.pm * BM + wr * 64 + fr, col0 = u.pn * BM + wc * 32 + 8 * fq;
        const float osc = oscp ? *oscp : 1.0f;
#pragma unroll
        for (int ai = 0; ai < 2; ++ai)
#pragma unroll
            for (int m = 0; m < 4; ++m) { bf16_t* rowp = O + (size_t)(row0 + ai * HALF + m * 16) * ldc + col0;
#pragma unroll
                for (int bj = 0; bj < 2; ++bj) *(u32x4*)(rowp + bj * HALF) = pack8(acc[ai][bj][m][0] * osc, acc[ai][bj][m][1] * osc); }
    }
};
constexpr float U8_SCALE = 8.0f;
__device__ __forceinline__ unsigned fp8x4(const f32x4 v) {
    const float a = __builtin_amdgcn_fmed3f(v[0] * U8_SCALE, -448.f, 448.f), b = __builtin_amdgcn_fmed3f(v[1] * U8_SCALE, -448.f, 448.f), c = __builtin_amdgcn_fmed3f(v[2] * U8_SCALE, -448.f, 448.f), d = __builtin_amdgcn_fmed3f(v[3] * U8_SCALE, -448.f, 448.f);
    int w = __builtin_amdgcn_cvt_pk_fp8_f32(a, b, 0, false); w = __builtin_amdgcn_cvt_pk_fp8_f32(c, d, w, true); return (unsigned)w;
}
template <bool I8, bool F8OUT> struct EpiSwiGLU {
    static constexpr bool PERM = true, AFTER_DRAIN = false, HAS_PRE = true;
    bf16_t* O; int ldc; const float* rstd; const float* sw; mutable float rsv[8]; mutable f32x4 swv[4];
    __device__ __forceinline__ void pre(const Unit& u, int wr, int wc, int fr, int fq) const {
        const int row0 = u.pm * BM + wr * 64 + fr;
#pragma unroll
        for (int i = 0; i < 8; ++i) rsv[i] = rstd[row0 + (i >> 2) * HALF + (i & 3) * 16];
    }
    __device__ __forceinline__ void operator()(const f32x4 (&acc)[2][2][4][2], const Unit& u, int wr, int wc, int fr, int fq) const {
        const int row0 = u.pm * BM + wr * 64 + fr, col0 = u.pn * HALF + wc * 32 + 8 * fq;
        if constexpr (I8) { const float* p = sw + u.pn * BM + wc * 32 + 8 * fq; swv[0] = *(const f32x4*)p; swv[1] = *(const f32x4*)(p + 4); swv[2] = *(const f32x4*)(p + HALF); swv[3] = *(const f32x4*)(p + HALF + 4); }
#pragma unroll
        for (int ai = 0; ai < 2; ++ai)
#pragma unroll
            for (int m = 0; m < 4; ++m) { bf16_t* rowp = O + (size_t)(row0 + ai * HALF + m * 16) * ldc + col0; const float rs = rsv[ai * 4 + m];
                f32x4 h0, h1;
                if constexpr (I8) { h0 = silu4(acc[ai][0][m][0] * (swv[0] * rs)) * (acc[ai][1][m][0] * (swv[2] * rs)); h1 = silu4(acc[ai][0][m][1] * (swv[1] * rs)) * (acc[ai][1][m][1] * (swv[3] * rs)); }
                else { h0 = silu4(acc[ai][0][m][0] * rs) * (acc[ai][1][m][0] * rs); h1 = silu4(acc[ai][0][m][1] * rs) * (acc[ai][1][m][1] * rs); }
                if constexpr (F8OUT) { u32x2 w8; w8.x = fp8x4(h0); w8.y = fp8x4(h1); *(u32x2*)((unsigned char*)O + (size_t)(row0 + ai * HALF + m * 16) * ldc + col0) = w8; }
                else *(u32x4*)rowp = pack8(h0, h1); }
    }
};
constexpr int SEQ_ = 4096, NTOK_ = 32768;
constexpr float QSCALE = 0.125f * 1.4426950408889634f;
template <int mode, bool I8> struct EpiHeads {
    static constexpr bool PERM = true, AFTER_DRAIN = false, HAS_PRE = false;
    bf16_t* qkv; float* gate; const float* cs; const float* sn; const float* rstd; const float* sw;
    __device__ __forceinline__ void operator()(const f32x4 (&acc)[2][2][4][2], const Unit& u, int wr, int wc, int fr, int fq) const {
        const int pn = u.pn, b = u.pm >> 4, t0 = (u.pm & 15) * BM + wr * 64 + fr;
        f32x4 swv[2][2];
        if constexpr (I8) { const float* sp = sw + pn * BM + wc * 32 + 8 * fq; swv[0][0] = *(const f32x4*)sp; swv[0][1] = *(const f32x4*)(sp + 4); swv[1][0] = *(const f32x4*)(sp + HALF); swv[1][1] = *(const f32x4*)(sp + HALF + 4); }
        if (mode == 2 && pn == 10) {
            const int col = wc * 32 + 8 * fq;
            if (col < 48) {
#pragma unroll
                for (int ai = 0; ai < 2; ++ai)
#pragma unroll
                    for (int m = 0; m < 4; ++m) { float* gp = gate + (size_t)(b * SEQ_ + t0 + ai * HALF + m * 16) * 48 + col; const float rs = rstd[b * SEQ_ + t0 + ai * HALF + m * 16];
                        f32x4 a = acc[ai][0][m][0] * rs, c = acc[ai][0][m][1] * rs;
                        if constexpr (I8) { a = a * swv[0][0]; c = c * swv[0][1]; }
                        *(f32x4*)gp = (f32x4){sigmoid_f(a[0]), sigmoid_f(a[1]), sigmoid_f(a[2]), sigmoid_f(a[3])};
                        *(f32x4*)(gp + 4) = (f32x4){sigmoid_f(c[0]), sigmoid_f(c[1]), sigmoid_f(c[2]), sigmoid_f(c[3])}; }
            }
            return;
        }
        bf16_t* tb; int nh, head0; bool hd128 = false, rope; float sc = 1.0f;
        if (mode == 2) {
            if (pn < 4) { tb = qkv; nh = 16; head0 = pn * 4; rope = true; sc = QSCALE; }
            else { tb = qkv + (size_t)NTOK_ * 1024 + (size_t)(pn - 4) * NTOK_ * 256; nh = 4; head0 = 0; rope = ((pn - 4) & 1) == 0; }
        } else {
            const int tensor = pn >> 2; tb = qkv + (size_t)tensor * NTOK_ * 1024; rope = tensor < 2; if (tensor == 0) sc = QSCALE;
            if (tensor == 2 && mode == 0) { hd128 = true; nh = 8; head0 = (pn & 3) * 2; } else { nh = 16; head0 = (pn & 3) * 4; }
        }
        const bool do_rope = rope && ((wc & 1) == 0);
        const float sgn = fq == 0 ? -1.0f : 1.0f;
#pragma unroll
        for (int ai = 0; ai < 2; ++ai)
#pragma unroll
            for (int m = 0; m < 4; ++m) {
                const int t = t0 + ai * HALF + m * 16; const float rs = rstd[b * SEQ_ + t];
                f32x4 c0 = {1.f, 1.f, 1.f, 1.f}, c1 = c0, s0 = {0.f, 0.f, 0.f, 0.f}, s1 = s0;
                if (do_rope) { c0 = *(const f32x4*)(cs + t * 8); c1 = *(const f32x4*)(cs + t * 8 + 4); s0 = *(const f32x4*)(sn + t * 8); s1 = *(const f32x4*)(sn + t * 8 + 4); }
#pragma unroll
                for (int bj = 0; bj < 2; ++bj) {
                    f32x4 v0 = acc[ai][bj][m][0], v1 = acc[ai][bj][m][1];
                    if constexpr (I8) { v0 = v0 * swv[bj][0]; v1 = v1 * swv[bj][1]; }
                    if (do_rope) {
                        f32x4 o0, o1;
#pragma unroll
                        for (int e = 0; e < 4; ++e) {
                            auto ra = __builtin_amdgcn_permlane16_swap(__float_as_uint(v0[e]), __float_as_uint(v0[e]), false, false);
                            auto rb = __builtin_amdgcn_permlane16_swap(__float_as_uint(v1[e]), __float_as_uint(v1[e]), false, false);
                            o0[e] = __uint_as_float((fq & 1) ? ra[0] : ra[1]); o1[e] = __uint_as_float((fq & 1) ? rb[0] : rb[1]); }
                        if (fq < 2) { v0 = v0 * c0 + (o0 * s0) * sgn; v1 = v1 * c1 + (o1 * s1) * sgn; }
                    }
                    v0 = v0 * (sc * rs); v1 = v1 * (sc * rs);
                    bf16_t* p;
                    if (hd128) p = tb + ((size_t)(b * 8 + head0 + bj) * SEQ_ + t) * 128 + wc * 32 + 8 * fq;
                    else p = tb + ((size_t)(b * nh + head0 + 2 * bj + (wc >> 1)) * SEQ_ + t) * 64 + (wc & 1) * 32 + 8 * fq;
                    *(u32x4*)p = pack8(v0, v1);
                }
            }
    }
};
struct EpiCmp1 {
    static constexpr bool PERM = true, AFTER_DRAIN = false, HAS_PRE = false;
    bf16_t* H; const float* bias;
    __device__ __forceinline__ void operator()(const f32x4 (&acc)[2][2][4][2], const Unit& u, int wr, int wc, int fr, int fq) const {
        const int row0 = u.pm * BM + wr * 64 + fr, col0 = wc * 32 + 8 * fq;
#pragma unroll
        for (int bj = 0; bj < 2; ++bj) { const f32x4 b0 = *(const f32x4*)(bias + u.pn * 256 + col0 + bj * HALF), b1 = *(const f32x4*)(bias + u.pn * 256 + col0 + bj * HALF + 4);
#pragma unroll
            for (int ai = 0; ai < 2; ++ai)
#pragma unroll
                for (int m = 0; m < 4; ++m) *(u32x4*)(H + (size_t)(row0 + ai * HALF + m * 16) * 256 + col0 + bj * HALF) = pack8(silu4(acc[ai][bj][m][0] + b0), silu4(acc[ai][bj][m][1] + b1)); }
    }
};
struct EpiCmp2 {
    static constexpr bool PERM = true, AFTER_DRAIN = false, HAS_PRE = false;
    bf16_t* O;
    __device__ __forceinline__ void operator()(const f32x4 (&acc)[2][2][4][2], const Unit& u, int wr, int wc, int fr, int fq) const {
        if (wc >= 2) return;
        const int row0 = u.pm * BM + wr * 64 + fr, col0 = wc * 32 + 8 * fq;
#pragma unroll
        for (int ai = 0; ai < 2; ++ai)
#pragma unroll
            for (int m = 0; m < 4; ++m) *(u32x4*)(O + (size_t)(row0 + ai * HALF + m * 16) * 64 + col0) = pack8(acc[ai][0][m][0], acc[ai][0][m][1]);
    }
};

template <int QM> struct FragT { typedef bf16x8 type; };
template <> struct FragT<2> { typedef i32x8 type; };
template <class Epi, class Sched, bool ALIGN_EPI = false, bool SP2 = false, int QM = 0>
__device__ __forceinline__ void gemm_phase(PG8_LAS unsigned char* lds, const Gemm g, const Sched& S, const Epi& E, int tid_) {
    asm volatile("" : "+v"(tid_));
    const int tid = tid_, wid = __builtin_amdgcn_readfirstlane(tid >> 6), lane = tid & 63, wr = wid >> 2, wc = wid & 3, fr = lane & 15, fq = lane >> 4;
    const int K = g.K, nt = K / BK;
    unsigned voffA[2], voffB[2];
#pragma unroll
    for (int i = 0; i < 2; ++i) { int R, C; stage_rc(tid * 16 + i * 8192, R, C); const int Rb = Epi::PERM ? ((R & ~31) + perm32(R & 31)) : R;
        voffA[i] = (unsigned)(R * g.lda + C) * 2u; voffB[i] = (unsigned)(Rb * K + C) * 2u; }
    const size_t kstep = (size_t)(BK * 2);
    const size_t hstepB = (size_t)HALF * K * 2, hstepA = (size_t)HALF * g.lda * 2;
    const size_t tstepA = 2 * hstepA, tstepB = 2 * hstepB;
    const unsigned ldsw = (unsigned)wid * 1024u;
    const int aoff = lds_byte(wr * 64 + fr, fq * 8), boff = lds_byte(wc * 32 + fr, fq * 8);
#define PG8_SA(b, h) (((b) * 2 + (h)) * HTB)
#define PG8_SB(b, h) ((4 + (b) * 2 + (h)) * HTB)
#define PG8_STAGE(bufoff, gbase, voff) do { _Pragma("unroll") for (int _i = 0; _i < 2; ++_i) \
        __builtin_amdgcn_global_load_lds((const unsigned*)((const char*)(gbase) + (voff)[_i]), (PG8_LAS unsigned*)(lds + (bufoff) + ldsw + _i * 8192), 16, 0, 0); } while (0)
#define PG8_LD32(p) __builtin_shufflevector(*(const PG8_LAS i32x4*)(p), *(const PG8_LAS i32x4*)((p) + 1024), 0, 1, 2, 3, 4, 5, 6, 7)
#define PG8_LDA(dst, b, h) do { if constexpr (QM == 2) { _Pragma("unroll") for (int m = 0; m < 4; ++m) dst[m][0] = PG8_LD32(lds + PG8_SA(b, h) + aoff + m * 2048); } \
        else { _Pragma("unroll") for (int m = 0; m < 4; ++m) { _Pragma("unroll") for (int k = 0; k < NKF; ++k) dst[m][k] = *(const PG8_LAS frag_t*)(lds + PG8_SA(b, h) + aoff + m * 2048 + k * 1024); } } } while (0)
#define PG8_LDB(dst, b, h) do { if constexpr (QM == 2) { _Pragma("unroll") for (int n = 0; n < 2; ++n) dst[n][0] = PG8_LD32(lds + PG8_SB(b, h) + boff + n * 2048); } \
        else { _Pragma("unroll") for (int n = 0; n < 2; ++n) { _Pragma("unroll") for (int k = 0; k < NKF; ++k) dst[n][k] = *(const PG8_LAS frag_t*)(lds + PG8_SB(b, h) + boff + n * 2048 + k * 1024); } } } while (0)
#define PG8_MMA(ai, bj, At, Bt) do { __builtin_amdgcn_s_setprio(1); \
        _Pragma("unroll") for (int m = 0; m < 4; ++m) { _Pragma("unroll") for (int n = 0; n < 2; ++n) { _Pragma("unroll") for (int k = 0; k < NKF; ++k) { \
            if constexpr (QM == 2) asm volatile("v_mfma_f32_16x16x128_f8f6f4 %0, %1, %2, %0" : "+v"(acc[ai][bj][m][n]) : "v"(Bt[n][k]), "v"(At[m][k]));   \
            else if constexpr (QM == 1) acc[ai][bj][m][n] = __builtin_bit_cast(f32x4, __builtin_amdgcn_mfma_i32_16x16x64_i8(__builtin_bit_cast(i32x4, Bt[n][k]), __builtin_bit_cast(i32x4, At[m][k]), __builtin_bit_cast(i32x4, acc[ai][bj][m][n]), 0, 0, 0)); \
            else acc[ai][bj][m][n] = __builtin_amdgcn_mfma_f32_16x16x32_bf16(Bt[n][k], At[m][k], acc[ai][bj][m][n], 0, 0, 0); } } } \
        __builtin_amdgcn_s_setprio(0); } while (0)
#define PG8_WAIT_V(n) asm volatile("s_waitcnt vmcnt(" #n ")" ::: "memory")
#define PG8_WAIT_L(n) asm volatile("s_waitcnt lgkmcnt(" #n ")" ::: "memory")
#define PG8_BAR __builtin_amdgcn_s_barrier()
#define PG8_SCHED __builtin_amdgcn_sched_barrier(0)
    Unit cur, nxt; int ui = 0;
    if (!S.next(0, cur)) return;
    f32x4 acc[2][2][4][2];
#pragma unroll
    for (int a = 0; a < 2; ++a)
#pragma unroll
        for (int b = 0; b < 2; ++b)
#pragma unroll
            for (int m = 0; m < 4; ++m)
#pragma unroll
                for (int n = 0; n < 2; ++n) acc[a][b][m][n] = (f32x4){0.f, 0.f, 0.f, 0.f};
    constexpr int NKF = QM == 2 ? 1 : 2;
    typedef typename FragT<QM>::type frag_t;
    frag_t At[4][NKF], B0[2][NKF], B1[2][NKF];
    const char* cA = (const char*)g.A + (size_t)cur.pm * tstepA; const char* cB = (const char*)g.Bt + (size_t)cur.pn * tstepB;
    S.a_ready(cur);
    if constexpr (SP2) {
        PG8_STAGE(PG8_SB(0, 0), cB, voffB); PG8_STAGE(PG8_SB(0, 1), cB + hstepB, voffB); PG8_STAGE(PG8_SA(0, 0), cA, voffA); PG8_STAGE(PG8_SA(0, 1), cA + hstepA, voffA);
        if (wr == 1) PG8_BAR;
        PG8_WAIT_V(2); PG8_BAR;
        PG8_STAGE(PG8_SB(1, 0), cB + kstep, voffB); PG8_STAGE(PG8_SA(1, 0), cA + kstep, voffA); PG8_STAGE(PG8_SB(1, 1), cB + hstepB + kstep, voffB);
        PG8_WAIT_V(6); PG8_BAR;
    } else {
        PG8_STAGE(PG8_SB(0, 0), cB, voffB); PG8_STAGE(PG8_SA(0, 0), cA, voffA); PG8_STAGE(PG8_SB(0, 1), cB + hstepB, voffB); PG8_STAGE(PG8_SA(0, 1), cA + hstepA, voffA);
        if (wr == 1) PG8_BAR;
        PG8_WAIT_V(4); PG8_BAR;
        PG8_STAGE(PG8_SB(1, 0), cB + kstep, voffB); PG8_STAGE(PG8_SA(1, 0), cA + kstep, voffA); PG8_STAGE(PG8_SB(1, 1), cB + hstepB + kstep, voffB);
        PG8_WAIT_V(6); PG8_BAR;
    }
    for (;;) {
        if constexpr (Epi::HAS_PRE) E.pre(cur, wr, wc, fr, fq);
        const bool has_next = S.next(ui + 1, nxt);
        const char* nA = has_next ? (const char*)g.A + (size_t)nxt.pm * tstepA : cA; const char* nB = has_next ? (const char*)g.Bt + (size_t)nxt.pn * tstepB : cB;
        for (int t = 0; t < nt; t += 2) {
            const bool last = (t == nt - 2);
            const char* a1 = cA + (size_t)(t + 1) * kstep;
            const char* a2 = last ? nA : cA + (size_t)(t + 2) * kstep; const char* b2 = last ? nB : cB + (size_t)(t + 2) * kstep;
            const char* a3 = a2 + kstep; const char* b3 = b2 + kstep;
            if (last && has_next) S.a_ready(nxt);
            if constexpr (SP2) {
            PG8_LDB(B0, 0, 0); PG8_LDB(B1, 0, 1); PG8_SCHED; PG8_LDA(At, 0, 0); PG8_STAGE(PG8_SA(1, 1), a1 + hstepA, voffA);
            PG8_WAIT_V(8); PG8_WAIT_L(0); PG8_BAR; PG8_MMA(0, 0, At, B0); PG8_MMA(0, 1, At, B1); PG8_BAR; PG8_SCHED;
            PG8_LDA(At, 0, 1); PG8_STAGE(PG8_SB(0, 0), b2, voffB); PG8_STAGE(PG8_SB(0, 1), b2 + hstepB, voffB); PG8_STAGE(PG8_SA(0, 0), a2, voffA);
            PG8_WAIT_V(8); PG8_WAIT_L(0); PG8_BAR; PG8_MMA(1, 0, At, B0); PG8_MMA(1, 1, At, B1); PG8_BAR; PG8_SCHED;
            PG8_LDB(B0, 1, 0); PG8_LDB(B1, 1, 1); PG8_SCHED; PG8_LDA(At, 1, 0); PG8_STAGE(PG8_SA(0, 1), a2 + hstepA, voffA);
            PG8_WAIT_V(8); PG8_WAIT_L(0); PG8_BAR; PG8_MMA(0, 0, At, B0); PG8_MMA(0, 1, At, B1); PG8_BAR; PG8_SCHED;
            PG8_LDA(At, 1, 1); PG8_STAGE(PG8_SB(1, 0), b3, voffB); PG8_STAGE(PG8_SB(1, 1), b3 + hstepB, voffB); PG8_STAGE(PG8_SA(1, 0), a3, voffA);
            PG8_WAIT_V(8); PG8_WAIT_L(0); PG8_BAR; PG8_MMA(1, 0, At, B0); PG8_MMA(1, 1, At, B1); PG8_BAR; PG8_SCHED;
            } else {
            PG8_LDB(B0, 0, 0); PG8_SCHED; PG8_LDA(At, 0, 0); PG8_STAGE(PG8_SA(1, 1), a1 + hstepA, voffA);
            PG8_WAIT_L(8); PG8_BAR; PG8_WAIT_L(0); PG8_MMA(0, 0, At, B0); PG8_BAR; PG8_SCHED;
            PG8_LDB(B1, 0, 1); PG8_STAGE(PG8_SB(0, 0), b2, voffB);
            PG8_BAR; PG8_WAIT_L(0); PG8_MMA(0, 1, At, B1); PG8_BAR;
            PG8_LDA(At, 0, 1); PG8_STAGE(PG8_SA(0, 0), a2, voffA);
            PG8_BAR; PG8_WAIT_L(0); PG8_MMA(1, 0, At, B0); PG8_BAR; PG8_SCHED;
            PG8_STAGE(PG8_SB(0, 1), b2 + hstepB, voffB);
            PG8_WAIT_V(6); PG8_BAR; PG8_MMA(1, 1, At, B1); PG8_BAR;
            PG8_LDB(B0, 1, 0); PG8_SCHED; PG8_LDA(At, 1, 0); PG8_STAGE(PG8_SA(0, 1), a2 + hstepA, voffA);
            PG8_WAIT_L(8); PG8_BAR; PG8_WAIT_L(0); PG8_MMA(0, 0, At, B0); PG8_BAR; PG8_SCHED;
            PG8_LDB(B1, 1, 1); PG8_STAGE(PG8_SB(1, 0), b3, voffB);
            PG8_BAR; PG8_WAIT_L(0); PG8_MMA(0, 1, At, B1); PG8_BAR;
            PG8_LDA(At, 1, 1); PG8_STAGE(PG8_SA(1, 0), a3, voffA);
            PG8_BAR; PG8_WAIT_L(0); PG8_MMA(1, 0, At, B0); PG8_BAR; PG8_SCHED;
            PG8_STAGE(PG8_SB(1, 1), b3 + hstepB, voffB);
            PG8_WAIT_V(6); PG8_BAR; PG8_MMA(1, 1, At, B1); PG8_BAR;
            }
        }
        if constexpr (ALIGN_EPI) { if (wr == 0) PG8_BAR; }
        if constexpr (QM == 2) asm volatile("s_nop 15\n\ts_nop 15\n\ts_nop 15" ::: "memory");
        if constexpr (QM == 1) {
#pragma unroll
            for (int a = 0; a < 2; ++a)
#pragma unroll
                for (int b = 0; b < 2; ++b)
#pragma unroll
                    for (int m = 0; m < 4; ++m)
#pragma unroll
                        for (int n = 0; n < 2; ++n) acc[a][b][m][n] = __builtin_convertvector(__builtin_bit_cast(i32x4, acc[a][b][m][n]), f32x4);
        }
        if constexpr (!Epi::AFTER_DRAIN) { E(acc, cur, wr, wc, fr, fq); S.done(cur); }
        if (!has_next) break;
#pragma unroll
        for (int a = 0; a < 2; ++a)
#pragma unroll
            for (int b = 0; b < 2; ++b)
#pragma unroll
                for (int m = 0; m < 4; ++m)
#pragma unroll
                    for (int n = 0; n < 2; ++n) acc[a][b][m][n] = (f32x4){0.f, 0.f, 0.f, 0.f};
        cur = nxt; cA = nA; cB = nB; ++ui;
        if constexpr (ALIGN_EPI) { if (wr == 1) PG8_BAR; }
    }
    PG8_WAIT_V(0);
    if constexpr (!ALIGN_EPI) { if (wr == 0) PG8_BAR; }
    PG8_BAR;
    if constexpr (Epi::AFTER_DRAIN) { E.fused(acc, cur, wr, wc, fr, fq, lds, wid, lane); S.done(cur); }
#undef PG8_SA
#undef PG8_SB
#undef PG8_STAGE
#undef PG8_LDA
#undef PG8_LD32
#undef PG8_LDB
#undef PG8_MMA
#undef PG8_WAIT_V
#undef PG8_WAIT_L
#undef PG8_BAR
#undef PG8_SCHED
}
}

constexpr int NWAVES = 8;
constexpr int BATCH = 8, SEQ = 4096, D = 1024, NTOK = BATCH * SEQ, DFF = 2816, DEPTH = 4;
constexpr float NORM_EPS = 1e-6f;
constexpr int NSA_IN = 2608, NSA_IN_PAD = 2816;

constexpr size_t MiB = 1u << 20;
constexpr size_t WS_CTL = 0, CTL_ZERO_BYTES = 32768;
constexpr size_t WS_TAB = 1 * MiB;
constexpr size_t TAB_COS = WS_TAB, TAB_SIN = WS_TAB + 128 * 1024, TAB_CBIAS = WS_TAB + 256 * 1024, TAB_LAM = WS_TAB + 260 * 1024, TAB_KMEAN = WS_TAB + 512 * 1024, TAB_RSTD = WS_TAB + 1024 * 1024, TAB_CBP = WS_TAB + 1152 * 1024, TAB_RS8 = WS_TAB + 1280 * 1024, TAB_SW = WS_TAB + 1408 * 1024, TAB_SWI = WS_TAB + 1600 * 1024, TAB_SW2 = WS_TAB + 1792 * 1024, TAB_SWI2 = WS_TAB + 1856 * 1024;
constexpr size_t WS_SEL = 3 * MiB;
constexpr size_t WS_GATE = 4 * MiB;
constexpr size_t WS_KVC = 10 * MiB;
constexpr size_t WS_CH = 12 * MiB;
constexpr size_t WS_W = 20 * MiB;
constexpr size_t W_FFN_IN = WS_W, FFN_IN_BYTES = (size_t)2 * DFF * D * 2;
constexpr size_t W_FFN_OUT = W_FFN_IN + 8 * FFN_IN_BYTES, FFN_OUT_BYTES = (size_t)D * DFF * 2;
constexpr size_t W_DIFF_IN = W_FFN_OUT + 8 * FFN_OUT_BYTES;
constexpr size_t W_DIFF_OUT = W_DIFF_IN + 2 * 6 * MiB;
constexpr size_t W_MOBA_IN = W_DIFF_OUT + 2 * 2 * MiB;
constexpr size_t W_MOBA_OUT = W_MOBA_IN + 6 * MiB;
constexpr size_t W_NSA_IN = W_MOBA_OUT + 2 * MiB;
constexpr size_t W_NSA_OUT = W_NSA_IN + (size_t)NSA_IN_PAD * D * 2;
constexpr size_t W_CMP1 = W_NSA_OUT + 2 * MiB;
constexpr size_t W_CMP2 = W_CMP1 + 2 * MiB;
constexpr size_t W_END = W_CMP2 + 256 * 1024;
constexpr size_t WS_XN = 188 * MiB;
constexpr size_t WS_Y = WS_XN + 64 * MiB;
constexpr size_t WS_ATT = WS_Y + 64 * MiB;
constexpr size_t WS_U = WS_ATT + 64 * MiB;
constexpr size_t WS_H8 = WS_U + 192 * MiB + 1 * MiB;
constexpr size_t WS_END = WS_H8 + 32 * MiB;
static_assert(W_END <= WS_XN, "weights overflow");

constexpr int CW_BAR = 4096;
constexpr int CW_WOMAX = 64;
constexpr float W8_TOP = 224.0f;

constexpr int LDS_BYTES = 147456;
constexpr int LDSCTL_OFF = LDS_BYTES - 512;

#define GAS __attribute__((address_space(1)))
#define LAS __attribute__((address_space(3)))
typedef unsigned short bf16;
typedef unsigned v4u __attribute__((ext_vector_type(4)));
typedef float f32x4 __attribute__((ext_vector_type(4)));
#define LDS_WAIT() asm volatile("s_waitcnt lgkmcnt(0)" ::: "memory")
__device__ __forceinline__ unsigned f2bf(float f) { unsigned u = __builtin_bit_cast(unsigned, f); return (u + 0x7fffu + ((u >> 16) & 1u)) >> 16; }
__device__ __forceinline__ unsigned pk2(float lo, float hi) { return f2bf(lo) | (f2bf(hi) << 16); }
__device__ __forceinline__ float bflo(unsigned u) { return __uint_as_float(u << 16); }
__device__ __forceinline__ float bfhi(unsigned u) { return __uint_as_float(u & 0xffff0000u); }
__device__ __forceinline__ float ex2(float x) { return __builtin_amdgcn_exp2f(x); }

#define XB_TMO      128
#define XB_XCNT(j)  (256  + 64 * (j))
#define XB_XSUB(j)  (1280 + 64 * (j))
#define XB_XGEN(j)  (2304 + 64 * (j))
#define XB_TOP      3328
#define XB_TOPGEN   3392
#define XCD_BAR_WORDS 3456
#define XB_SPIN_CAP (1u << 18)

__device__ __forceinline__ unsigned xb_ld(unsigned* p)              { return __hip_atomic_load(p, __ATOMIC_RELAXED, __HIP_MEMORY_SCOPE_AGENT); }
__device__ __forceinline__ unsigned xb_add(unsigned* p, unsigned v) { return __hip_atomic_fetch_add(p, v, __ATOMIC_RELAXED, __HIP_MEMORY_SCOPE_AGENT); }
__device__ __forceinline__ unsigned xb_xcc_id() { return (unsigned)__builtin_amdgcn_s_getreg((3 << 11) | 20) & 0xFu; }
#define XB_SPIN(cond, bar) do { unsigned _sp = 0; while (cond) { __builtin_amdgcn_s_sleep(1); \
    if ((++_sp & 255u) == 0u) { if (xb_ld(&(bar)[XB_TMO])) break; if (_sp > XB_SPIN_CAP) { atomicAdd(&(bar)[XB_TMO], 1u); break; } } } } while (0)

struct XcdBarrier {
    unsigned* bar; unsigned x;
    volatile LAS unsigned* st;
};

__device__ __forceinline__ XcdBarrier xcd_barrier_post(unsigned* bar, volatile LAS unsigned* st) {
    XcdBarrier b; b.bar = bar; b.x = xb_xcc_id(); b.st = st;
    if (threadIdx.x == 0) (void)xb_add(&bar[XB_XCNT(b.x)], 1u);
    return b;
}
__device__ __forceinline__ void xcd_barrier_complete(unsigned* bar, unsigned x, unsigned& nloc, unsigned& nx) {
    const unsigned G = gridDim.x * gridDim.y * gridDim.z;
    unsigned sum, cnt, mine, sp = 0u;
    for (;;) {
        sum = 0u; cnt = 0u; mine = 0u;
#pragma unroll
        for (unsigned j = 0; j < 16; ++j) { const unsigned c = xb_ld(&bar[XB_XCNT(j)]); sum += c; cnt += (c > 0u) ? 1u : 0u; mine = (j == x) ? c : mine; }
        if (sum == G) break;
        __builtin_amdgcn_s_sleep(1);
        if ((++sp & 255u) == 0u) { if (xb_ld(&bar[XB_TMO])) break; if (sp > XB_SPIN_CAP) { atomicAdd(&bar[XB_TMO], 1u); break; } }
    }
    nloc = mine > 0u ? mine : 1u; nx = cnt > 0u ? cnt : 1u;
}

__device__ __forceinline__ void xcd_barrier(const XcdBarrier& b, bool t0) {
    asm volatile("s_waitcnt vmcnt(0)" ::: "memory");
    __syncthreads();
    if (t0) {
        unsigned* bar = b.bar;
        __builtin_amdgcn_s_waitcnt(0);
        unsigned nloc = b.st[0], nx = b.st[1];
        if (nloc == 0u) { xcd_barrier_complete(bar, b.x, nloc, nx); b.st[0] = nloc; b.st[1] = nx; }
        const unsigned old = xb_add(&bar[XB_XSUB(b.x)], 1u);
        const unsigned gen = old / nloc;
        if (old + 1u == (gen + 1u) * nloc) {
            __builtin_amdgcn_fence(__ATOMIC_RELEASE, "agent");
            asm volatile("s_waitcnt vmcnt(0)" ::: "memory");
            const unsigned og = xb_add(&bar[XB_TOP], 1u);
            const unsigned tg = og / nx;
            if (og + 1u == (tg + 1u) * nx) xb_add(&bar[XB_TOPGEN], 1u);
            else XB_SPIN(xb_ld(&bar[XB_TOPGEN]) == tg, bar);
            __builtin_amdgcn_fence(__ATOMIC_ACQUIRE, "agent");
            xb_add(&bar[XB_XGEN(b.x)], 1u);
            asm volatile("s_waitcnt vmcnt(0)" ::: "memory");
        } else {
            XB_SPIN(xb_ld(&bar[XB_XGEN(b.x)]) == gen, bar);
            __builtin_amdgcn_fence(__ATOMIC_ACQUIRE, "agent");
            asm volatile("s_waitcnt vmcnt(0)" ::: "memory");
        }
    }
    __syncthreads();
}

struct Args { const float* in[15]; float* out; unsigned char* ws; };
struct InPtrs { const Args* a; __device__ __forceinline__ const float* operator[](int i) const { return a->in[i]; } };
struct Frame {
    LAS unsigned char* lds;
    volatile LAS unsigned* MISC;
    int tid, lane, wave, G, vcu;
    InPtrs in; float* out; unsigned char* ws;
};
template <int CTRL> __device__ __forceinline__ float dpp_mov(float v) { return __builtin_bit_cast(float, __builtin_amdgcn_update_dpp(0, __builtin_bit_cast(int, v), CTRL, 0xF, 0xF, true)); }
__device__ __forceinline__ float wave_sum(float v) {
    v += dpp_mov<0xB1>(v); v += dpp_mov<0x4E>(v); v += dpp_mov<0x141>(v); v += dpp_mov<0x140>(v);
    { auto r = __builtin_amdgcn_permlane16_swap(__float_as_uint(v), __float_as_uint(v), false, false); v = __uint_as_float(r[0]) + __uint_as_float(r[1]); }
    { auto r = __builtin_amdgcn_permlane32_swap(__float_as_uint(v), __float_as_uint(v), false, false); v = __uint_as_float(r[0]) + __uint_as_float(r[1]); }
    return v;
}
__device__ __forceinline__ float wave_max(float v) {
    v = fmaxf(v, dpp_mov<0xB1>(v)); v = fmaxf(v, dpp_mov<0x4E>(v)); v = fmaxf(v, dpp_mov<0x141>(v)); v = fmaxf(v, dpp_mov<0x140>(v));
    { auto r = __builtin_amdgcn_permlane16_swap(__float_as_uint(v), __float_as_uint(v), false, false); v = fmaxf(__uint_as_float(r[0]), __uint_as_float(r[1])); }
    { auto r = __builtin_amdgcn_permlane32_swap(__float_as_uint(v), __float_as_uint(v), false, false); v = fmaxf(__uint_as_float(r[0]), __uint_as_float(r[1])); }
    return v;
}
__device__ __forceinline__ unsigned q8x4(float a, float b, float c, float d) {
    const int ia = (int)__builtin_rintf(a), ib = (int)__builtin_rintf(b), ic = (int)__builtin_rintf(c), id = (int)__builtin_rintf(d);
    return ((unsigned)ia & 255u) | (((unsigned)ib & 255u) << 8) | (((unsigned)ic & 255u) << 16) | ((unsigned)id << 24);
}

__device__ __forceinline__ void phase_sync(Frame& F, const XcdBarrier& bar) {
    xcd_barrier(bar, F.tid == 0);
    int l; asm volatile("v_mbcnt_lo_u32_b32 %0, -1, 0\n\tv_mbcnt_hi_u32_b32 %0, -1, %0" : "=v"(l));
    F.lane = l; F.tid = F.wave * 64 + l;
}
__device__ __forceinline__ void conv_load(const float* W, int N, int item, int nblk, int lane, float (&v)[32]) {
    const int kb = item / nblk, nb = item % nblk, k0 = 64 * kb, n0 = 32 * nb;
    const int col = n0 + (lane & 31); const bool ok = col < N;
    const float* p = W + (size_t)(k0 + (lane >> 5)) * N + col;
#pragma unroll
    for (int i = 0; i < 32; ++i) v[i] = ok ? p[(size_t)(2 * i) * N] : 0.f;
}
__device__ __forceinline__ void conv_store(const float (&v)[32], int K, bf16* WT, int mode, LAS float* scr, int item, int nblk, int lane, const float* gk, const float* swi, const float* womax) {
    const int kb = item / nblk, nb = item % nblk, k0 = 64 * kb, n0 = 32 * nb;
#pragma unroll
    for (int i = 0; i < 32; ++i) scr[(2 * i + (lane >> 5)) * 33 + (lane & 31)] = v[i];
    LDS_WAIT(); asm volatile("" ::: "memory");
    int r0 = n0;
    if (mode == 1) { const int up = n0 >= DFF ? 1 : 0, j = n0 - up * DFF; r0 = 256 * (j >> 7) + 128 * up + (j & 127); }
    const int c = lane & 7;
    f32x4 g0 = {1.f, 1.f, 1.f, 1.f}, g1 = g0;
    if (gk) { g0 = *(const f32x4*)(gk + k0 + 8 * c); g1 = *(const f32x4*)(gk + k0 + 8 * c + 4); }
#pragma unroll
    for (int j = 0; j < 4; ++j) { const int n = (lane >> 3) + 8 * j; const LAS float* s = scr + (8 * c) * 33 + n;
        v4u o; o.x = pk2(s[0 * 33] * g0[0], s[1 * 33] * g0[1]); o.y = pk2(s[2 * 33] * g0[2], s[3 * 33] * g0[3]); o.z = pk2(s[4 * 33] * g1[0], s[5 * 33] * g1[1]); o.w = pk2(s[6 * 33] * g1[2], s[7 * 33] * g1[3]);
        if (womax) { const float am = *womax, qf = am > 0.f ? W8_TOP / am : 0.f; typedef unsigned u2 __attribute__((ext_vector_type(2)));
            int w0 = __builtin_amdgcn_cvt_pk_fp8_f32(s[0 * 33] * qf, s[1 * 33] * qf, 0, false); w0 = __builtin_amdgcn_cvt_pk_fp8_f32(s[2 * 33] * qf, s[3 * 33] * qf, w0, true);
            int w1 = __builtin_amdgcn_cvt_pk_fp8_f32(s[4 * 33] * qf, s[5 * 33] * qf, 0, false); w1 = __builtin_amdgcn_cvt_pk_fp8_f32(s[6 * 33] * qf, s[7 * 33] * qf, w1, true);
            u2 o8; o8.x = (unsigned)w0; o8.y = (unsigned)w1; *(GAS u2*)((unsigned char*)WT + (size_t)(r0 + n) * K + k0 + 8 * c) = o8; continue; }
        if (swi) { const float qi = swi[r0 + n]; typedef unsigned u2 __attribute__((ext_vector_type(2)));
            u2 o8; o8.x = q8x4(s[0 * 33] * g0[0] * qi, s[1 * 33] * g0[1] * qi, s[2 * 33] * g0[2] * qi, s[3 * 33] * g0[3] * qi); o8.y = q8x4(s[4 * 33] * g1[0] * qi, s[5 * 33] * g1[1] * qi, s[6 * 33] * g1[2] * qi, s[7 * 33] * g1[3] * qi);
            *(GAS u2*)((unsigned char*)WT + (size_t)(r0 + n) * K + k0 + 8 * c) = o8; continue; }
        *(GAS v4u*)(WT + (size_t)(r0 + n) * K + k0 + 8 * c) = o; }
    LDS_WAIT(); asm volatile("" ::: "memory");
}
__device__ __forceinline__ void conv_matrix(Frame& F, int& base, const float* W, int K, int N, int Npad, bf16* WT, int mode, const float* gk = nullptr, const float* swi = nullptr, const float* womax = nullptr) {
    LAS float* scr = (LAS float*)(F.lds + F.wave * 16384);
    const int gw = blockIdx.x * NWAVES + F.wave, NGW = F.G * NWAVES;
    const int nblk = Npad / 32, items = (K / 64) * nblk;
    int it = (gw + NGW - base % NGW) % NGW;
    base += items;
    float v[32];
    if (it < items) conv_load(W, N, it, nblk, F.lane, v);
    while (it < items) {
        const int nx = it + NGW; float v2[32];
        if (nx < items) conv_load(W, N, nx, nblk, F.lane, v2);
        conv_store(v, K, WT, mode, scr, it, nblk, F.lane, gk, swi, womax);
#pragma unroll
        for (int i = 0; i < 32; ++i) v[i] = v2[i];
        it = nx;
    }
}

constexpr int RPT = 4;
__device__ __forceinline__ void rows_phase(Frame& F, const float* x, const bf16* y, float coef, const float* gpost, bf16* H, float* RS, float* fout) {
    unsigned char* H8 = F.ws + WS_H8; float* RS8 = (float*)(F.ws + TAB_RS8);
    const int gw = blockIdx.x * NWAVES + F.wave, NGW = F.G * NWAVES;
    int lane_ = F.lane; asm volatile("" : "+v"(lane_));
    const int c0 = 8 * lane_;
    float gp[16];
#pragma unroll
    for (int k = 0; k < 16; ++k) gp[k] = y ? gpost[c0 + (k >> 3) * 512 + (k & 7)] : 0.f;
    for (int row0 = gw; row0 < NTOK; row0 += RPT * NGW) {
        float hv[RPT][16], yv[RPT][16];
#pragma unroll
        for (int u = 0; u < RPT; ++u) {
            const int row = row0 + u * NGW; if (row >= NTOK) break;
            if (y) {
                const bf16* hr = H + (size_t)row * D + c0; const bf16* yr = y + (size_t)row * D + c0;
#pragma unroll
                for (int j = 0; j < 2; ++j) { const v4u w = *(const v4u*)(hr + j * 512), q = *(const v4u*)(yr + j * 512);
                    hv[u][8 * j + 0] = bflo(w.x); hv[u][8 * j + 1] = bfhi(w.x); hv[u][8 * j + 2] = bflo(w.y); hv[u][8 * j + 3] = bfhi(w.y); hv[u][8 * j + 4] = bflo(w.z); hv[u][8 * j + 5] = bfhi(w.z); hv[u][8 * j + 6] = bflo(w.w); hv[u][8 * j + 7] = bfhi(w.w);
                    yv[u][8 * j + 0] = bflo(q.x); yv[u][8 * j + 1] = bfhi(q.x); yv[u][8 * j + 2] = bflo(q.y); yv[u][8 * j + 3] = bfhi(q.y); yv[u][8 * j + 4] = bflo(q.z); yv[u][8 * j + 5] = bfhi(q.z); yv[u][8 * j + 6] = bflo(q.w); yv[u][8 * j + 7] = bfhi(q.w); }
            } else {
                const float* xr = x + (size_t)row * D + c0;
#pragma unroll
                for (int j = 0; j < 2; ++j) { const f32x4 a = *(const f32x4*)(xr + j * 512), b = *(const f32x4*)(xr + j * 512 + 4);
                    hv[u][8 * j + 0] = a[0]; hv[u][8 * j + 1] = a[1]; hv[u][8 * j + 2] = a[2]; hv[u][8 * j + 3] = a[3]; hv[u][8 * j + 4] = b[0]; hv[u][8 * j + 5] = b[1]; hv[u][8 * j + 6] = b[2]; hv[u][8 * j + 7] = b[3]; }
            }
        }
#pragma unroll
        for (int u = 0; u < RPT; ++u) {
            const int row = row0 + u * NGW; if (row >= NTOK) break;
            if (y) {
                float ss = 0.f;
#pragma unroll
                for (int k = 0; k < 16; ++k) ss += yv[u][k] * yv[u][k];
                ss = wave_sum(ss);
                const float r = coef * __builtin_amdgcn_rsqf(ss * (1.0f / D) + NORM_EPS);
#pragma unroll
                for (int k = 0; k < 16; ++k) hv[u][k] += yv[u][k] * r * gp[k];
            }
            if (fout) {
                float* ho = fout + (size_t)row * D + c0;
#pragma unroll
                for (int j = 0; j < 2; ++j) { *(f32x4*)(ho + j * 512) = (f32x4){hv[u][8 * j], hv[u][8 * j + 1], hv[u][8 * j + 2], hv[u][8 * j + 3]}; *(f32x4*)(ho + j * 512 + 4) = (f32x4){hv[u][8 * j + 4], hv[u][8 * j + 5], hv[u][8 * j + 6], hv[u][8 * j + 7]}; }
            } else {
                float ss = 0.f;
#pragma unroll
                for (int k = 0; k < 16; ++k) ss += hv[u][k] * hv[u][k];
                ss = wave_sum(ss);
                const float rstd = __builtin_amdgcn_rsqf(ss * (1.0f / D) + NORM_EPS);
                float am = 0.f;
#pragma unroll
                for (int k = 0; k < 16; ++k) am = fmaxf(am, fabsf(hv[u][k]));
                am = wave_max(am);
                const float qs = am > 0.f ? 127.0f / am : 0.f;
                if (lane_ == 0) { RS[row] = rstd; RS8[row] = rstd * am * (1.0f / 127.0f); }
                typedef unsigned u2 __attribute__((ext_vector_type(2)));
#pragma unroll
                for (int j = 0; j < 2; ++j) { u2 w8; w8.x = q8x4(hv[u][8 * j] * qs, hv[u][8 * j + 1] * qs, hv[u][8 * j + 2] * qs, hv[u][8 * j + 3] * qs); w8.y = q8x4(hv[u][8 * j + 4] * qs, hv[u][8 * j + 5] * qs, hv[u][8 * j + 6] * qs, hv[u][8 * j + 7] * qs);
                    *(u2*)(H8 + (size_t)row * D + c0 + j * 512) = w8; }
                bf16* hw = H + (size_t)row * D + c0;
#pragma unroll
                for (int j = 0; j < 2; ++j) { v4u w; w.x = pk2(hv[u][8 * j], hv[u][8 * j + 1]); w.y = pk2(hv[u][8 * j + 2], hv[u][8 * j + 3]); w.z = pk2(hv[u][8 * j + 4], hv[u][8 * j + 5]); w.w = pk2(hv[u][8 * j + 6], hv[u][8 * j + 7]);
                    *(v4u*)(hw + j * 512) = w; }
            }
        }
    }
}

__device__ __forceinline__ void load_row64(const bf16* p, float (&q)[64]) {
#pragma unroll
    for (int i = 0; i < 8; ++i) { const v4u w = ((const v4u*)p)[i];
        q[8 * i + 0] = bflo(w.x); q[8 * i + 1] = bfhi(w.x); q[8 * i + 2] = bflo(w.y); q[8 * i + 3] = bfhi(w.y); q[8 * i + 4] = bflo(w.z); q[8 * i + 5] = bfhi(w.z); q[8 * i + 6] = bflo(w.w); q[8 * i + 7] = bfhi(w.w); }
}
__device__ __forceinline__ float dot64_bf(const float (&q)[64], const bf16* kp) {
    float s0 = 0.f, s1 = 0.f, s2 = 0.f, s3 = 0.f;
#pragma unroll
    for (int i = 0; i < 8; ++i) { const v4u w = ((const v4u*)kp)[i];
        s0 += q[8 * i + 0] * bflo(w.x); s1 += q[8 * i + 1] * bfhi(w.x); s2 += q[8 * i + 2] * bflo(w.y); s3 += q[8 * i + 3] * bfhi(w.y);
        s0 += q[8 * i + 4] * bflo(w.z); s1 += q[8 * i + 5] * bfhi(w.z); s2 += q[8 * i + 6] * bflo(w.w); s3 += q[8 * i + 7] * bfhi(w.w); }
    return (s0 + s1) + (s2 + s3);
}
template <int DV>
__device__ __forceinline__ void attend_key(const float (&q)[64], const bf16* kp, const bf16* vp, bool valid, float& m, float& l, float (&o)[DV]) {
    const float s = dot64_bf(q, kp);
    if (valid) {
        const float mn = fmaxf(m, s), a = ex2(m - mn), p = ex2(s - mn); l = l * a + p; m = mn;
#pragma unroll
        for (int i = 0; i < DV / 8; ++i) { const v4u w = ((const v4u*)vp)[i];
            o[8 * i + 0] = o[8 * i + 0] * a + p * bflo(w.x); o[8 * i + 1] = o[8 * i + 1] * a + p * bfhi(w.x); o[8 * i + 2] = o[8 * i + 2] * a + p * bflo(w.y); o[8 * i + 3] = o[8 * i + 3] * a + p * bfhi(w.y);
            o[8 * i + 4] = o[8 * i + 4] * a + p * bflo(w.z); o[8 * i + 5] = o[8 * i + 5] * a + p * bfhi(w.z); o[8 * i + 6] = o[8 * i + 6] * a + p * bflo(w.w); o[8 * i + 7] = o[8 * i + 7] * a + p * bfhi(w.w); }
    }
}
__device__ __forceinline__ int qperm(int slot) { const int g = slot >> 2, j = slot & 3; return j == 0 ? g : (j == 1 ? 15 - g : (j == 2 ? 7 - g : 8 + g)); }
template <int DV>
__device__ __forceinline__ void store_row_bf16(bf16* op, const float (&o)[DV], float sc) {
#pragma unroll
    for (int i = 0; i < DV / 8; ++i) { v4u w; w.x = pk2(o[8 * i] * sc, o[8 * i + 1] * sc); w.y = pk2(o[8 * i + 2] * sc, o[8 * i + 3] * sc); w.z = pk2(o[8 * i + 4] * sc, o[8 * i + 5] * sc); w.w = pk2(o[8 * i + 6] * sc, o[8 * i + 7] * sc);
        ((v4u*)op)[i] = w; }
}

__device__ __forceinline__ void diff_attn_slow(Frame& F, const bf16* Q, const bf16* K, const bf16* V, bf16* ATT, float lam, float lambda_init, const float* subln) {
    LAS float* X = (LAS float*)F.lds;
    for (int wslot = blockIdx.x; wslot < 256; wslot += F.G)
        for (int i = 0; i < 4; ++i) {
            const int id = wslot * 4 + i, bh = id >> 4, qb = qperm(id & 15), b = bh >> 3, h = bh & 7;
            const int c = F.wave >> 2, row = F.tid & 255, t = qb * 256 + row, sub = h * 2 + c;
            float q[64]; load_row64(Q + ((size_t)(b * 16 + sub) * SEQ + t) * 64, q);
            const bf16* Kb = K + (size_t)(b * 16 + sub) * SEQ * 64; const bf16* Vb = V + (size_t)(b * 8 + h) * SEQ * 128;
            const int tmax = __builtin_amdgcn_readfirstlane(qb * 256 + (row | 63));
            float ss = 0.f;
            for (int dh = 0; dh < 2; ++dh) {
                float m = -INFINITY, l = 0.f; float o[64];
#pragma unroll
                for (int d = 0; d < 64; ++d) o[d] = 0.f;
                for (int key = 0; key <= tmax; ++key) attend_key<64>(q, Kb + (size_t)key * 64, Vb + (size_t)key * 128 + dh * 64, key <= t, m, l, o);
                const float il = 1.0f / l;
                if (c == 1) {
#pragma unroll
                    for (int d = 0; d < 64; ++d) X[row * 129 + dh * 64 + d] = o[d] * il * lam;
                }
                __syncthreads();
                if (c == 0) {
#pragma unroll
                    for (int d = 0; d < 64; ++d) { const float a = o[d] * il - X[row * 129 + dh * 64 + d]; ss += a * a; X[row * 129 + dh * 64 + d] = a * subln[dh * 64 + d]; }
                }
            }
            if (c == 0) {
                const float r = __builtin_amdgcn_rsqf(ss * (1.0f / 128.0f) + 1e-5f) * (1.0f - lambda_init);
                bf16* op = ATT + (size_t)(b * SEQ + t) * D + h * 128;
#pragma unroll
                for (int i8 = 0; i8 < 16; ++i8) { const LAS float* xr = X + row * 129 + i8 * 8; v4u w; w.x = pk2(xr[0] * r, xr[1] * r); w.y = pk2(xr[2] * r, xr[3] * r); w.z = pk2(xr[4] * r, xr[5] * r); w.w = pk2(xr[6] * r, xr[7] * r); ((v4u*)op)[i8] = w; }
            }
            __syncthreads();
        }
}

__device__ __forceinline__ void moba_kmean(Frame& F, const bf16* K, float* KM) {
    const int gw = blockIdx.x * NWAVES + F.wave, NGW = F.G * NWAVES;
    for (int task = gw; task < BATCH * 16 * 16; task += NGW) {
        const int bh = task >> 4, n = task & 15; const bf16* kp = K + ((size_t)bh * SEQ + n * 256 + (F.lane >> 3)) * 64 + (F.lane & 7) * 8;
        float s[8];
#pragma unroll
        for (int e = 0; e < 8; ++e) s[e] = 0.f;
#pragma unroll
        for (int i = 0; i < 32; ++i) { const v4u w = *(const v4u*)(kp + (size_t)i * 8 * 64);
            s[0] += bflo(w.x); s[1] += bfhi(w.x); s[2] += bflo(w.y); s[3] += bfhi(w.y); s[4] += bflo(w.z); s[5] += bfhi(w.z); s[6] += bflo(w.w); s[7] += bfhi(w.w); }
#pragma unroll
        for (int e = 0; e < 8; ++e) { s[e] += __shfl_xor(s[e], 8); s[e] += __shfl_xor(s[e], 16); s[e] += __shfl_xor(s[e], 32); }
        if (F.lane < 8) { float* o = KM + (size_t)task * 64 + F.lane * 8;
            *(f32x4*)o = (f32x4){s[0], s[1], s[2], s[3]} * (1.0f / 256.0f); *(f32x4*)(o + 4) = (f32x4){s[4], s[5], s[6], s[7]} * (1.0f / 256.0f); }
    }
}
__device__ __forceinline__ void moba_attn_slow(Frame& F, const bf16* Q, const bf16* K, const bf16* V, const float* KM, bf16* ATT) {
    for (int wslot = blockIdx.x; wslot < 256; wslot += F.G)
        for (int i = 0; i < 4; ++i) {
            const int id = wslot * 4 + i, bhp = id >> 4, qb = qperm(id & 15), b = bhp >> 3, h = (bhp & 7) * 2 + (F.wave >> 2);
            const int row = F.tid & 255, t = qb * 256 + row;
            float q[64]; load_row64(Q + ((size_t)(b * 16 + h) * SEQ + t) * 64, q);
            const bf16* Kb = K + (size_t)(b * 16 + h) * SEQ * 64; const bf16* Vb = V + (size_t)(b * 16 + h) * SEQ * 64;
            const float* km = KM + (size_t)(b * 16 + h) * 16 * 64;
            unsigned bits = 0u;
            if (qb <= 3) bits = (1u << qb) - 1u;
            else {
                float v1 = -INFINITY, v2 = -INFINITY, v3 = -INFINITY; int i1 = 0, i2 = 0, i3 = 0;
                for (int n = 0; n < qb; ++n) {
                    float g0 = 0.f, g1 = 0.f;
#pragma unroll
                    for (int d = 0; d < 64; d += 2) { g0 += q[d] * km[n * 64 + d]; g1 += q[d + 1] * km[n * 64 + d + 1]; }
                    const float g = g0 + g1;
                    if (g > v1) { v3 = v2; i3 = i2; v2 = v1; i2 = i1; v1 = g; i1 = n; }
                    else if (g > v2) { v3 = v2; i3 = i2; v2 = g; i2 = n; }
                    else if (g > v3) { v3 = g; i3 = n; }
                }
                bits = (1u << i1) | (1u << i2) | (1u << i3);
            }
            float m = -INFINITY, l = 0.f; float o[64];
#pragma unroll
            for (int d = 0; d < 64; ++d) o[d] = 0.f;
            for (int n = 0; n < qb; ++n) {
                const bool sel = (bits >> n) & 1u;
                if (__any(sel)) for (int k = 0; k < 256; ++k) { const int key = n * 256 + k; attend_key<64>(q, Kb + (size_t)key * 64, Vb + (size_t)key * 64, sel, m, l, o); }
            }
            const int tmax = __builtin_amdgcn_readfirstlane(qb * 256 + (row | 63));
            for (int key = qb * 256; key <= tmax; ++key) attend_key<64>(q, Kb + (size_t)key * 64, Vb + (size_t)key * 64, key <= t, m, l, o);
            store_row_bf16<64>(ATT + (size_t)(b * SEQ + t) * D + h * 64, o, 1.0f / l);
        }
}

__device__ __forceinline__ void nsa_select_slow(Frame& F, const bf16* Q, const bf16* KC, unsigned long long* SEL) {
    LAS float* imp = (LAS float*)F.lds + F.tid * 65;
    for (int pass = blockIdx.x; pass < 256; pass += F.G) {
        const int id = pass * 2 + (F.wave >> 2), bg = id >> 4, qb = id & 15, b = bg >> 2, g = bg & 3;
        const int row = F.tid & 255, t = qb * 256 + row;
        for (int j = 0; j < 64; ++j) imp[j] = 0.f;
        const int nmax = t >= 31 ? (((t - 31) >> 4) < 254 ? ((t - 31) >> 4) : 254) : -1;
        const int tw = qb * 256 + (row | 63);
        const int wnmax = __builtin_amdgcn_readfirstlane(((tw - 31) >> 4) < 254 ? ((tw - 31) >> 4) : 254);
        const bf16* kc = KC + (size_t)(b * 4 + g) * 256 * 64;
        for (int r = 0; r < 4; ++r) {
            float q[64]; load_row64(Q + ((size_t)(b * 16 + g * 4 + r) * SEQ + t) * 64, q);
            float m = -INFINITY, l = 0.f;
            for (int n = 0; n <= wnmax; ++n) { const float s = dot64_bf(q, kc + n * 64); if (n <= nmax) { const float mn = fmaxf(m, s); l = l * ex2(m - mn) + ex2(s - mn); m = mn; } }
            const float il = l > 0.f ? 1.0f / l : 0.f;
            for (int n = 0; n <= wnmax; ++n) { const float s = dot64_bf(q, kc + n * 64);
                if (n <= nmax) { const float p = ex2(s - m) * il; imp[n >> 2] += p; if ((n & 3) == 3) imp[(n >> 2) + 1] += p; } }
        }
        const int qblk = t >> 6;
        unsigned long long bits;
        if (qblk < 16) bits = (2ull << qblk) - 1ull;
        else {
            bits = 1ull | (1ull << qblk) | (1ull << (qblk - 1));
            for (int it = 0; it < 13; ++it) {
                float best = -1.0f; int bi = 1;
                for (int j = 1; j <= qblk - 2; ++j) { const float v = imp[j]; if (!((bits >> j) & 1ull) && v > best) { best = v; bi = j; } }
                bits |= 1ull << bi;
            }
        }
        SEL[(size_t)(b * 4 + g) * SEQ + t] = bits;
    }
}
__device__ __forceinline__ void nsa_attn_slow(Frame& F, const bf16* Q, const bf16* KVC, const bf16* KS, const bf16* VS, const bf16* KW, const bf16* VW, const float* GATE, const unsigned long long* SEL, bf16* ATT) {
    for (int wslot = blockIdx.x; wslot < 256; wslot += F.G)
        for (int i = 0; i < 4; ++i) {
            const int id = wslot * 4 + i, bhp = id >> 4, qb = qperm(id & 15), b = bhp >> 3, h = (bhp & 7) * 2 + (F.wave >> 2), g = h >> 2;
            const int row = F.tid & 255, t = qb * 256 + row;
            float q[64]; load_row64(Q + ((size_t)(b * 16 + h) * SEQ + t) * 64, q);
            const float* gt = GATE + (size_t)(b * SEQ + t) * 48 + h * 3; const float g0 = gt[0], g1 = gt[1], g2 = gt[2];
            LAS float* ot = (LAS float*)F.lds + F.tid * 65; float o[64];
#pragma unroll
            for (int d = 0; d < 64; ++d) o[d] = 0.f;
            float m = -INFINITY, l = 0.f;
            {
                const int nmax = t >= 31 ? (((t - 31) >> 4) < 254 ? ((t - 31) >> 4) : 254) : -1;
                const int tw = qb * 256 + (row | 63);
                const int wnmax = __builtin_amdgcn_readfirstlane(((tw - 31) >> 4) < 254 ? ((tw - 31) >> 4) : 254);
                const bf16* kc = KVC + (size_t)(b * 4 + g) * 256 * 64; const bf16* vc = kc + (size_t)BATCH * 4 * 256 * 64;
#pragma unroll 1
                for (int n = 0; n <= wnmax; ++n) attend_key<64>(q, kc + n * 64, vc + n * 64, n <= nmax, m, l, o);
                const float w = l > 0.f ? g0 / l : 0.f;
#pragma unroll
                for (int d = 0; d < 64; ++d) { ot[d] = w * o[d]; o[d] = 0.f; }
                asm volatile("" ::: "memory");
            }
            {
                m = -INFINITY; l = 0.f;
                const unsigned long long bits = SEL[(size_t)(b * 4 + g) * SEQ + t];
                const bf16* kb = KS + (size_t)(b * 4 + g) * SEQ * 64; const bf16* vb = VS + (size_t)(b * 4 + g) * SEQ * 64;
                const int qblk = __builtin_amdgcn_readfirstlane(t >> 6);
#pragma unroll 1
                for (int j = 0; j <= qblk; ++j) {
                    const bool sel = (bits >> j) & 1ull;
                    if (__any(sel))
#pragma unroll 1
                    for (int k = 0; k < 64; ++k) { const int key = j * 64 + k; attend_key<64>(q, kb + (size_t)key * 64, vb + (size_t)key * 64, sel && key <= t, m, l, o); }
                }
                const float w = l > 0.f ? g1 / l : 0.f;
#pragma unroll
                for (int d = 0; d < 64; ++d) { ot[d] += w * o[d]; o[d] = 0.f; }
                asm volatile("" ::: "memory");
            }
            {
                m = -INFINITY; l = 0.f;
                const bf16* kb = KW + (size_t)(b * 4 + g) * SEQ * 64; const bf16* vb = VW + (size_t)(b * 4 + g) * SEQ * 64;
                const int tlo = (t & ~63) - 511, lo = __builtin_amdgcn_readfirstlane(tlo < 0 ? 0 : tlo), hi = __builtin_amdgcn_readfirstlane(t | 63);
#pragma unroll 1
                for (int key = lo; key <= hi; ++key) attend_key<64>(q, kb + (size_t)key * 64, vb + (size_t)key * 64, key <= t && key > t - 512, m, l, o);
                const float w = l > 0.f ? g2 / l : 0.f;
#pragma unroll
                for (int d = 0; d < 64; ++d) o[d] = ot[d] + w * o[d];
            }
            store_row_bf16<64>(ATT + (size_t)(b * SEQ + t) * D + h * 64, o, 1.0f);
        }
}


namespace fa {
typedef short bf16x8 __attribute__((ext_vector_type(8)));
typedef float f32x16 __attribute__((ext_vector_type(16)));
typedef short s16x4 __attribute__((ext_vector_type(4)));
typedef unsigned u32x4_t __attribute__((ext_vector_type(4)));
__device__ __forceinline__ int crow(int r, int hi) { return (r & 3) + 8 * (r >> 2) + 4 * hi; }
__device__ __forceinline__ float xmax(float x) { auto rr = __builtin_amdgcn_permlane32_swap(__float_as_uint(x), __float_as_uint(x), false, false); return fmaxf(__uint_as_float(rr[0]), __uint_as_float(rr[1])); }
__device__ __forceinline__ float xsum(float x) { auto rr = __builtin_amdgcn_permlane32_swap(__float_as_uint(x), __float_as_uint(x), false, false); return __uint_as_float(rr[0]) + __uint_as_float(rr[1]); }
__device__ __forceinline__ void dma16(const void* g, LAS unsigned char* l) {
    unsigned keep; const unsigned dst = (unsigned)__builtin_amdgcn_readfirstlane((unsigned)(uintptr_t)l);
    asm volatile("s_mov_b32 %0, m0\n\ts_mov_b32 m0, %2\n\ts_nop 0\n\tglobal_load_lds_dwordx4 %1, off\n\ts_mov_b32 m0, %0" : "=&s"(keep) : "v"(g), "s"(dst) : "memory");
}
__device__ __forceinline__ void dma16s(const void* sbase, unsigned voff, LAS unsigned char* l) {
    unsigned keep; const unsigned dst = (unsigned)__builtin_amdgcn_readfirstlane((unsigned)(uintptr_t)l);
    asm volatile("s_mov_b32 %0, m0\n\ts_mov_b32 m0, %3\n\ts_nop 0\n\tglobal_load_lds_dwordx4 %1, %2\n\ts_mov_b32 m0, %0" : "=&s"(keep) : "v"(voff), "s"(sbase), "s"(dst) : "memory");
}
__device__ __forceinline__ s16x4 vtr(const LAS unsigned char* p) { return __builtin_bit_cast(s16x4, __builtin_amdgcn_ds_read_tr16_b64_v4i16((LAS s16x4*)p)); }
__device__ __forceinline__ unsigned cvtpk(float lo, float hi) { unsigned r; asm volatile("v_cvt_pk_bf16_f32 %0, %1, %2" : "=v"(r) : "v"(lo), "v"(hi)); return r; }
#define FA_RINGBAR2(ahead) do { if ((ahead) >= 2) asm volatile("s_waitcnt vmcnt(4) lgkmcnt(0)" ::: "memory"); else if ((ahead) == 1) asm volatile("s_waitcnt vmcnt(2) lgkmcnt(0)" ::: "memory"); else asm volatile("s_waitcnt vmcnt(0) lgkmcnt(0)" ::: "memory"); \
    __builtin_amdgcn_s_barrier(); asm volatile("" ::: "memory"); } while (0)
#define FA_RINGBAR4(ahead) do { if ((ahead) >= 2) asm volatile("s_waitcnt vmcnt(8) lgkmcnt(0)" ::: "memory"); else if ((ahead) == 1) asm volatile("s_waitcnt vmcnt(4) lgkmcnt(0)" ::: "memory"); else asm volatile("s_waitcnt vmcnt(0) lgkmcnt(0)" ::: "memory"); \
    __builtin_amdgcn_s_barrier(); asm volatile("" ::: "memory"); } while (0)
#define FA_WAITBAR() do { asm volatile("s_waitcnt vmcnt(0) lgkmcnt(0)" ::: "memory"); __builtin_amdgcn_s_barrier(); asm volatile("" ::: "memory"); } while (0)

__device__ __forceinline__ void stage_k64(const bf16* kt, LAS unsigned char* dst, int wave, int lane) {
    const int k = wave * 8 + (lane >> 3), c = (lane & 7) ^ ((k >> 1) & 7);
    dma16(kt + (size_t)k * 64 + c * 8, dst + wave * 1024);
}
__device__ __forceinline__ void stage_v64(const bf16* vt, LAS unsigned char* dst, int wave, int lane) { dma16(vt + (size_t)(16 * (wave & 3) + (lane >> 2)) * 64 + 32 * (wave >> 2) + 8 * (lane & 3), dst + wave * 1024); }

__device__ __forceinline__ void edge_mask(f32x16& p0, f32x16& p1, int lim_lo, int lim_hi, int hi) {
    int ll = lim_lo - 4 * hi, lh = lim_hi - 4 * hi;
    asm volatile("" : "+v"(ll), "+v"(lh));
#pragma unroll
    for (int r = 0; r < 16; ++r) { const int k0 = (r & 3) + 8 * (r >> 2); if (k0 > lh || k0 <= ll) p0[r] = -INFINITY; if (k0 + 32 > lh || k0 + 32 <= ll) p1[r] = -INFINITY; }
}
__device__ __forceinline__ void scores_c(const LAS unsigned char* Kt, const bf16x8 (&qr)[4], const f32x16& c, f32x16& p0, f32x16& p1, int lane) {
    const int k = lane & 31, hi = lane >> 5, sw = (k >> 1) & 7;
    const LAS unsigned char* kb = Kt + k * 128;
    bf16x8 a0[4], a1[4];
#pragma unroll
    for (int d0 = 0; d0 < 4; ++d0) { const int off = ((2 * d0 + hi) ^ sw) * 16; a0[d0] = *(const LAS bf16x8*)(kb + off); a1[d0] = *(const LAS bf16x8*)(kb + 4096 + off); }
    p0 = __builtin_amdgcn_mfma_f32_32x32x16_bf16(a0[0], qr[0], c, 0, 0, 0); p1 = __builtin_amdgcn_mfma_f32_32x32x16_bf16(a1[0], qr[0], c, 0, 0, 0);
#pragma unroll
    for (int d0 = 1; d0 < 4; ++d0) { p0 = __builtin_amdgcn_mfma_f32_32x32x16_bf16(a0[d0], qr[d0], p0, 0, 0, 0); p1 = __builtin_amdgcn_mfma_f32_32x32x16_bf16(a1[d0], qr[d0], p1, 0, 0, 0); }
}
__device__ __forceinline__ void scores(const LAS unsigned char* Kt, const bf16x8 (&qr)[4], f32x16& p0, f32x16& p1, int lane) {
    f32x16 z;
#pragma unroll
    for (int r = 0; r < 16; ++r) z[r] = 0.f;
    scores_c(Kt, qr, z, p0, p1, lane);
}
__device__ __forceinline__ float max3f(float a, float b, float c) { float r; asm("v_max3_f32 %0, %1, %2, %3" : "=v"(r) : "v"(a), "v"(b), "v"(c)); return r; }
__device__ __forceinline__ float rowmax32(const f32x16& p0, const f32x16& p1) {
    float a = max3f(p0[0], p0[1], p1[0]), b = max3f(p0[2], p0[3], p1[1]); a = max3f(a, p1[2], p1[3]);
#pragma unroll
    for (int r = 4; r < 16; r += 4) { a = max3f(a, p0[r], p0[r + 1]); b = max3f(b, p0[r + 2], p0[r + 3]); a = max3f(a, p1[r], p1[r + 1]); b = max3f(b, p1[r + 2], p1[r + 3]); }
    return xmax(fmaxf(a, b));
}
template <int NDB>
__device__ __forceinline__ void vfrag(const LAS unsigned char* vb, int s, bf16x8 (&vf)[NDB]) {
#pragma unroll
    for (int db = 0; db < NDB; ++db) { const s16x4 lo = vtr(vb + db * 4096 + s * 1024), hi4 = vtr(vb + db * 4096 + s * 1024 + 512); vf[db] = (bf16x8){lo[0], lo[1], lo[2], lo[3], hi4[0], hi4[1], hi4[2], hi4[3]}; }
}
template <int NDB>
__device__ __forceinline__ void pv(const LAS unsigned char* Vt, const bf16x8 (&pw)[4], f32x16 (&o)[NDB], int lane) {
    const LAS unsigned char* vb = Vt + ((lane >> 4) & 1) * 32 + (lane & 3) * 8 + (4 * (lane >> 5) + ((lane & 15) >> 2)) * 64;
    bf16x8 va[NDB], vbq[NDB];
    vfrag<NDB>(vb, 0, va);
    vfrag<NDB>(vb, 1, vbq);
    __builtin_amdgcn_sched_barrier(0);
#pragma unroll
    for (int db = 0; db < NDB; ++db) o[db] = __builtin_amdgcn_mfma_f32_32x32x16_bf16(va[db], pw[0], o[db], 0, 0, 0);
    vfrag<NDB>(vb, 2, va);
    __builtin_amdgcn_sched_barrier(0);
#pragma unroll
    for (int db = 0; db < NDB; ++db) o[db] = __builtin_amdgcn_mfma_f32_32x32x16_bf16(vbq[db], pw[1], o[db], 0, 0, 0);
    vfrag<NDB>(vb, 3, vbq);
    __builtin_amdgcn_sched_barrier(0);
#pragma unroll
    for (int db = 0; db < NDB; ++db) o[db] = __builtin_amdgcn_mfma_f32_32x32x16_bf16(va[db], pw[2], o[db], 0, 0, 0);
#pragma unroll
    for (int db = 0; db < NDB; ++db) o[db] = __builtin_amdgcn_mfma_f32_32x32x16_bf16(vbq[db], pw[3], o[db], 0, 0, 0);
    __builtin_amdgcn_sched_barrier(0);
}
__device__ __forceinline__ void pack_p(const f32x16& p0, const f32x16& p1, bf16x8 (&pw)[4]) {
    typedef unsigned u4 __attribute__((ext_vector_type(4)));
    const u4 w0 = {cvtpk(p0[0], p0[1]), cvtpk(p0[2], p0[3]), cvtpk(p0[4], p0[5]), cvtpk(p0[6], p0[7])}, w1 = {cvtpk(p0[8], p0[9]), cvtpk(p0[10], p0[11]), cvtpk(p0[12], p0[13]), cvtpk(p0[14], p0[15])};
    const u4 w2 = {cvtpk(p1[0], p1[1]), cvtpk(p1[2], p1[3]), cvtpk(p1[4], p1[5]), cvtpk(p1[6], p1[7])}, w3 = {cvtpk(p1[8], p1[9]), cvtpk(p1[10], p1[11]), cvtpk(p1[12], p1[13]), cvtpk(p1[14], p1[15])};
    pw[0] = __builtin_bit_cast(bf16x8, w0); pw[1] = __builtin_bit_cast(bf16x8, w1); pw[2] = __builtin_bit_cast(bf16x8, w2); pw[3] = __builtin_bit_cast(bf16x8, w3);
}
constexpr float FA_THR = 8.0f;
struct RowState { f32x16 negm; float mref, l; bool seen; };
__device__ __forceinline__ void row_init(RowState& s) { s.mref = 0.f; s.l = 0.f; s.seen = false;
#pragma unroll
    for (int r = 0; r < 16; ++r) s.negm[r] = 0.f; }
template <int NDB>
__device__ __forceinline__ void attn_tile(const LAS unsigned char* Kt, const LAS unsigned char* Vt, const bf16x8 (&qr)[4], RowState& st, f32x16 (&o)[NDB], bool edge, int lim_lo, int lim_hi, bool use_keep, bool keep, int lane) {
    f32x16 p0, p1;
    if (use_keep) { f32x16 c;
#pragma unroll
        for (int r = 0; r < 16; ++r) c[r] = keep ? st.negm[r] : -INFINITY;
        scores_c(Kt, qr, c, p0, p1, lane);
    } else scores_c(Kt, qr, st.negm, p0, p1, lane);
    if (edge) edge_mask(p0, p1, lim_lo, lim_hi, lane >> 5);
    const float mx = rowmax32(p0, p1);
    const bool vis = mx > -INFINITY, cond = (mx > FA_THR) || (!st.seen && vis);
    if (__any(cond)) {
        const float dl = cond ? mx : 0.f, alpha = st.seen ? ex2(-dl) : 1.0f;
        st.mref += dl; st.l *= alpha;
#pragma unroll
        for (int r = 0; r < 16; ++r) { p0[r] -= dl; p1[r] -= dl; st.negm[r] = -st.mref; }
#pragma unroll
        for (int db = 0; db < NDB; ++db)
#pragma unroll
            for (int r = 0; r < 16; ++r) o[db][r] *= alpha;
    }
    st.seen = st.seen || vis;
    float ps0 = 0.f, ps1 = 0.f;
#pragma unroll
    for (int r = 0; r < 16; ++r) { p0[r] = ex2(p0[r]); p1[r] = ex2(p1[r]); ps0 += p0[r]; ps1 += p1[r]; }
    st.l += ps0 + ps1;
    bf16x8 pw[4]; pack_p(p0, p1, pw);
    __builtin_amdgcn_sched_barrier(0);
    pv<NDB>(Vt, pw, o, lane);
    __builtin_amdgcn_sched_barrier(0);
}
template <int NDB>
__device__ __forceinline__ void store_ot(bf16* rowp, const f32x16 (&o)[NDB], float sc, int hi) {
    typedef unsigned u2 __attribute__((ext_vector_type(2)));
#pragma unroll
    for (int db = 0; db < NDB; ++db)
#pragma unroll
        for (int rq = 0; rq < 4; ++rq) { u2 w; w.x = cvtpk(o[db][4 * rq] * sc, o[db][4 * rq + 1] * sc); w.y = cvtpk(o[db][4 * rq + 2] * sc, o[db][4 * rq + 3] * sc);
            *(u2*)(rowp + 32 * db + 8 * rq + 4 * hi) = w; }
}
struct RowState2 { float mref, l; bool seen; };
__device__ __forceinline__ void row_init2(RowState2& s) { s.mref = 0.f; s.l = 0.f; s.seen = false; }
__device__ __forceinline__ void scores2(const LAS unsigned char* Kt, const bf16x8 (&qa)[4], const bf16x8 (&qb)[4], float cA, float cB, f32x16& a0p, f32x16& a1p, f32x16& b0p, f32x16& b1p, int lane) {
    const int k = lane & 31, hi = lane >> 5, sw = (k >> 1) & 7;
    const LAS unsigned char* kb = Kt + k * 128;
    bf16x8 x0, x1, y0, y1;
    { const int off = ((0 + hi) ^ sw) * 16; x0 = *(const LAS bf16x8*)(kb + off); x1 = *(const LAS bf16x8*)(kb + 4096 + off); }
    { const int off = ((2 + hi) ^ sw) * 16; y0 = *(const LAS bf16x8*)(kb + off); y1 = *(const LAS bf16x8*)(kb + 4096 + off); }
    f32x16 c;
#pragma unroll
    for (int r = 0; r < 16; ++r) c[r] = cA;
    a0p = __builtin_amdgcn_mfma_f32_32x32x16_bf16(x0, qa[0], c, 0, 0, 0); a1p = __builtin_amdgcn_mfma_f32_32x32x16_bf16(x1, qa[0], c, 0, 0, 0);
#pragma unroll
    for (int r = 0; r < 16; ++r) c[r] = cB;
    b0p = __builtin_amdgcn_mfma_f32_32x32x16_bf16(x0, qb[0], c, 0, 0, 0); b1p = __builtin_amdgcn_mfma_f32_32x32x16_bf16(x1, qb[0], c, 0, 0, 0);
    __builtin_amdgcn_sched_barrier(0);
    { const int off = ((4 + hi) ^ sw) * 16; x0 = *(const LAS bf16x8*)(kb + off); x1 = *(const LAS bf16x8*)(kb + 4096 + off); }
    a0p = __builtin_amdgcn_mfma_f32_32x32x16_bf16(y0, qa[1], a0p, 0, 0, 0); a1p = __builtin_amdgcn_mfma_f32_32x32x16_bf16(y1, qa[1], a1p, 0, 0, 0);
    b0p = __builtin_amdgcn_mfma_f32_32x32x16_bf16(y0, qb[1], b0p, 0, 0, 0); b1p = __builtin_amdgcn_mfma_f32_32x32x16_bf16(y1, qb[1], b1p, 0, 0, 0);
    __builtin_amdgcn_sched_barrier(0);
    { const int off = ((6 + hi) ^ sw) * 16; y0 = *(const LAS bf16x8*)(kb + off); y1 = *(const LAS bf16x8*)(kb + 4096 + off); }
    a0p = __builtin_amdgcn_mfma_f32_32x32x16_bf16(x0, qa[2], a0p, 0, 0, 0); a1p = __builtin_amdgcn_mfma_f32_32x32x16_bf16(x1, qa[2], a1p, 0, 0, 0);
    b0p = __builtin_amdgcn_mfma_f32_32x32x16_bf16(x0, qb[2], b0p, 0, 0, 0); b1p = __builtin_amdgcn_mfma_f32_32x32x16_bf16(x1, qb[2], b1p, 0, 0, 0);
    __builtin_amdgcn_sched_barrier(0);
    a0p = __builtin_amdgcn_mfma_f32_32x32x16_bf16(y0, qa[3], a0p, 0, 0, 0); a1p = __builtin_amdgcn_mfma_f32_32x32x16_bf16(y1, qa[3], a1p, 0, 0, 0);
    b0p = __builtin_amdgcn_mfma_f32_32x32x16_bf16(y0, qb[3], b0p, 0, 0, 0); b1p = __builtin_amdgcn_mfma_f32_32x32x16_bf16(y1, qb[3], b1p, 0, 0, 0);
    __builtin_amdgcn_sched_barrier(0);
}
template <int NDB>
__device__ __forceinline__ void softmax_pack(f32x16& p0, f32x16& p1, RowState2& st, f32x16 (&o)[NDB], bf16x8 (&pw)[4], bool edge, int lim_lo, int lim_hi, int lane) {
    if (edge) edge_mask(p0, p1, lim_lo, lim_hi, lane >> 5);
    const float mx = rowmax32(p0, p1);
    const bool vis = mx > -INFINITY, cond = (mx > FA_THR) || (!st.seen && vis);
    if (__any(cond)) {
        const float dl = cond ? mx : 0.f, alpha = st.seen ? ex2(-dl) : 1.0f;
        st.mref += dl; st.l *= alpha;
#pragma unroll
        for (int r = 0; r < 16; ++r) { p0[r] -= dl; p1[r] -= dl; }
#pragma unroll
        for (int db = 0; db < NDB; ++db)
#pragma unroll
            for (int r = 0; r < 16; ++r) o[db][r] *= alpha;
    }
    st.seen = st.seen || vis;
    float ps0 = 0.f, ps1 = 0.f;
#pragma unroll
    for (int r = 0; r < 16; ++r) { p0[r] = ex2(p0[r]); p1[r] = ex2(p1[r]); ps0 += p0[r]; ps1 += p1[r]; }
    st.l += ps0 + ps1;
    pack_p(p0, p1, pw);
}
__device__ __forceinline__ void pv2(const LAS unsigned char* Vt, const bf16x8 (&pa)[4], const bf16x8 (&pb)[4], f32x16 (&oa)[2], f32x16 (&ob)[2], int lane) {
    const LAS unsigned char* vb = Vt + ((lane >> 4) & 1) * 32 + (lane & 3) * 8 + (4 * (lane >> 5) + ((lane & 15) >> 2)) * 64;
#pragma unroll
    for (int s = 0; s < 4; ++s) {
        bf16x8 va[2];
        vfrag<2>(vb, s, va);
        __builtin_amdgcn_sched_barrier(0);
#pragma unroll
        for (int db = 0; db < 2; ++db) { oa[db] = __builtin_amdgcn_mfma_f32_32x32x16_bf16(va[db], pa[s], oa[db], 0, 0, 0); ob[db] = __builtin_amdgcn_mfma_f32_32x32x16_bf16(va[db], pb[s], ob[db], 0, 0, 0); }
        __builtin_amdgcn_sched_barrier(0);
    }
}
}

__device__ __forceinline__ void diff_attn_fast(Frame& F, const bf16* Q, const bf16* K, const bf16* V, bf16* ATT, float lam, float lambda_init, const float* subln) {
    using namespace fa;
    int lane_ = F.lane; asm volatile("" : "+v"(lane_));
    const int lane = lane_, wave = F.wave, r32 = lane & 31, hi = lane >> 5, c = wave >> 2, w = wave & 3;
    LAS unsigned char* L = F.lds;
    LAS float* SGL = (LAS float*)(L + 131072);
    if (F.tid < 128) SGL[F.tid] = subln[F.tid];
    for (int slot = F.vcu; slot < 256; slot += F.G)
        for (int i = 0; i < 8; ++i) {
            const int bh = (slot >> 5) * 8 + (i >> 1) * 2 + ((slot >> 4) & 1), pq = slot & 15, qb = (i & 1) ? 31 - pq : pq, b = bh >> 3, h = bh & 7;
            const int t = qb * 128 + w * 32 + r32;
            const bf16* Qp = Q + ((size_t)(b * 16 + h * 2 + c) * SEQ + t) * 64 + hi * 8;
            bf16x8 qr[4];
#pragma unroll
            for (int d0 = 0; d0 < 4; ++d0) qr[d0] = *(const bf16x8*)(Qp + d0 * 16);
            asm volatile("" : "+v"(qr[0]), "+v"(qr[1]), "+v"(qr[2]), "+v"(qr[3]));
            const bf16* K0 = K + (size_t)(b * 16 + h * 2) * SEQ * 64; const bf16* K1 = K0 + (size_t)SEQ * 64; const bf16* Vb = V + (size_t)(b * 8 + h) * SEQ * 128;
            const int nt = 2 * qb + 2, tl = 2 * qb + (w >> 1);
            f32x16 o[4]; RowState st; row_init(st);
#pragma unroll
            for (int db = 0; db < 4; ++db)
#pragma unroll
                for (int r = 0; r < 16; ++r) o[db][r] = 0.f;
#define DIFF_STAGE(j, buf) do { LAS unsigned char* B_ = L + (buf) * 32768; \
                stage_k64(K0 + (size_t)(j) * 4096, B_, wave, lane); stage_k64(K1 + (size_t)(j) * 4096, B_ + 8192, wave, lane); \
                _Pragma("unroll") for (int pp_ = 0; pp_ < 2; ++pp_) { const int pi_ = wave + 8 * pp_; \
                    dma16(Vb + (size_t)((j) * 64 + 16 * (pi_ & 3) + (lane >> 2)) * 128 + 32 * (pi_ >> 2) + 8 * (lane & 3), B_ + 16384 + pi_ * 1024); } } while (0)
            for (int jj = 0; jj < 3 && jj < nt; ++jj) DIFF_STAGE(jj, jj);
            for (int j = 0; j < nt; ++j) {
                const int ahead = nt - 1 - j;
                FA_RINGBAR4(ahead);
                if (j + 3 < nt) DIFF_STAGE(j + 3, (j + 3) & 3);
                if (j <= tl) {
                    const LAS unsigned char* B = L + (j & 3) * 32768;
                    attn_tile<4>(B + c * 8192, B + 16384, qr, st, o, j == tl, -1, t - j * 64, false, true, lane);
                }
            }
#undef DIFF_STAGE
            FA_WAITBAR();
            const float inv = 1.0f / xsum(st.l);
            LAS float* X = (LAS float*)L + (size_t)(w * 64) * 64 + lane;
            if (c == 1) {
#pragma unroll
                for (int db = 0; db < 4; ++db)
#pragma unroll
                    for (int r = 0; r < 16; ++r) X[(db * 16 + r) * 64] = o[db][r] * inv * lam;
            }
            FA_WAITBAR();
            if (c == 0) {
                float ss = 0.f;
#pragma unroll
                for (int db = 0; db < 4; ++db)
#pragma unroll
                    for (int r = 0; r < 16; ++r) { const float a = o[db][r] * inv - X[(db * 16 + r) * 64]; o[db][r] = a; ss += a * a; }
                ss = xsum(ss);
                const float rr = __builtin_amdgcn_rsqf(ss * (1.0f / 128.0f) + 1e-5f) * (1.0f - lambda_init);
                bf16* rowp = ATT + (size_t)(b * SEQ + t) * D + h * 128;
                typedef unsigned u2 __attribute__((ext_vector_type(2)));
#pragma unroll
                for (int db = 0; db < 4; ++db)
#pragma unroll
                    for (int rq = 0; rq < 4; ++rq) { const f32x4 sg = *(const LAS f32x4*)(SGL + 32 * db + 8 * rq + 4 * hi);
                        u2 wv; wv.x = cvtpk(o[db][4 * rq] * rr * sg[0], o[db][4 * rq + 1] * rr * sg[1]); wv.y = cvtpk(o[db][4 * rq + 2] * rr * sg[2], o[db][4 * rq + 3] * rr * sg[3]);
                        *(u2*)(rowp + 32 * db + 8 * rq + 4 * hi) = wv; }
            }
            FA_WAITBAR();
        }
}

namespace fa {
#define FA_PIN(x) asm volatile("" : "+v"(x))
struct PipeState { f32x16 negm; float l, alpha; };
template <bool HAS_NEXT>
__device__ __forceinline__ void diff_step(const LAS unsigned char* Kn, const LAS unsigned char* Vt, const bf16x8 (&qr)[4], f32x16& c0, f32x16& c1, f32x16& n0, f32x16& n1, PipeState& st, f32x16 (&o)[4],
                                          bool edge_next, int lim_hi_next, int lane) {
    const int k = lane & 31, hi = lane >> 5, sw = (k >> 1) & 7;
    if (__any(st.alpha != 1.0f)) {
#pragma unroll
        for (int db = 0; db < 4; ++db)
#pragma unroll
            for (int r = 0; r < 16; ++r) o[db][r] *= st.alpha;
        st.alpha = 1.0f;
    }
    u32x4_t pwv[4]; float ps = 0.f;
    const unsigned ka = (unsigned)(uintptr_t)Kn + (unsigned)(k * 128 + (hi ^ sw) * 16);
#define KFRAG(d0, half) (*(const LAS bf16x8*)(uintptr_t)((ka ^ (32u * (d0))) + 4096u * (half)))
    if constexpr (HAS_NEXT) {
        bf16x8 x0 = KFRAG(0, 0), y0 = KFRAG(1, 0);
        __builtin_amdgcn_sched_barrier(0);
#pragma unroll
        for (int g = 0; g < 4; ++g) {
            if (g == 0) n0 = __builtin_amdgcn_mfma_f32_32x32x16_bf16(x0, qr[0], st.negm, 0, 0, 0);
            else if (g == 1) n0 = __builtin_amdgcn_mfma_f32_32x32x16_bf16(y0, qr[1], n0, 0, 0, 0);
            else if (g == 2) n0 = __builtin_amdgcn_mfma_f32_32x32x16_bf16(x0, qr[2], n0, 0, 0, 0);
            else n0 = __builtin_amdgcn_mfma_f32_32x32x16_bf16(y0, qr[3], n0, 0, 0, 0);
            if (g == 0) x0 = KFRAG(2, 0);
            if (g == 1) y0 = KFRAG(3, 0);
#pragma unroll
            for (int e = 0; e < 4; ++e) c0[4 * g + e] = ex2(c0[4 * g + e]);
            ps += (c0[4 * g] + c0[4 * g + 1]) + (c0[4 * g + 2] + c0[4 * g + 3]);
            pwv[g >> 1][2 * (g & 1)] = cvtpk(c0[4 * g], c0[4 * g + 1]); pwv[g >> 1][2 * (g & 1) + 1] = cvtpk(c0[4 * g + 2], c0[4 * g + 3]);
            FA_PIN(pwv[g >> 1]); FA_PIN(ps);
            __builtin_amdgcn_sched_barrier(0);
        }
    } else {
#pragma unroll
        for (int g = 0; g < 8; ++g) { c0[2 * g] = ex2(c0[2 * g]); c0[2 * g + 1] = ex2(c0[2 * g + 1]); ps += c0[2 * g] + c0[2 * g + 1]; pwv[g >> 2][g & 3] = cvtpk(c0[2 * g], c0[2 * g + 1]); }
    }
    const LAS unsigned char* vb = Vt + ((lane >> 4) & 1) * 32 + (lane & 3) * 8 + (4 * (lane >> 5) + ((lane & 15) >> 2)) * 64;
#define FA_VF(m) ({ const s16x4 lo_ = vtr(vb + ((m) & 3) * 4096 + ((m) >> 2) * 1024), hi_ = vtr(vb + ((m) & 3) * 4096 + ((m) >> 2) * 1024 + 512); (bf16x8){lo_[0], lo_[1], lo_[2], lo_[3], hi_[0], hi_[1], hi_[2], hi_[3]}; })
    bf16x8 vf[5];
#pragma unroll
    for (int m = 0; m < 5; ++m) vf[m] = FA_VF(m);
    __builtin_amdgcn_sched_barrier(0);
#pragma unroll
    for (int m = 0; m < 8; ++m) {
        const int sl = m >> 2, db = m & 3;
        o[db] = __builtin_amdgcn_mfma_f32_32x32x16_bf16(vf[m % 5], __builtin_bit_cast(bf16x8, pwv[sl]), o[db], 0, 0, 0);
        vf[m % 5] = FA_VF(m + 5);
        c1[2 * m] = ex2(c1[2 * m]); c1[2 * m + 1] = ex2(c1[2 * m + 1]); ps += c1[2 * m] + c1[2 * m + 1]; pwv[2 + sl][db] = cvtpk(c1[2 * m], c1[2 * m + 1]); FA_PIN(pwv[2 + sl]); FA_PIN(ps);
        __builtin_amdgcn_sched_barrier(0);
    }
    st.l += ps;
    if constexpr (HAS_NEXT) {
        bf16x8 x1 = KFRAG(0, 1), y1 = KFRAG(1, 1);
        __builtin_amdgcn_sched_barrier(0);
        n1 = __builtin_amdgcn_mfma_f32_32x32x16_bf16(x1, qr[0], st.negm, 0, 0, 0);
        x1 = KFRAG(2, 1);
        __builtin_amdgcn_sched_barrier(0);
        n1 = __builtin_amdgcn_mfma_f32_32x32x16_bf16(y1, qr[1], n1, 0, 0, 0);
        y1 = KFRAG(3, 1);
        __builtin_amdgcn_sched_barrier(0);
        n1 = __builtin_amdgcn_mfma_f32_32x32x16_bf16(x1, qr[2], n1, 0, 0, 0);
        n1 = __builtin_amdgcn_mfma_f32_32x32x16_bf16(y1, qr[3], n1, 0, 0, 0);
    }
    __builtin_amdgcn_sched_barrier(0);
    float mx = 0.f;
#pragma unroll
    for (int m = 8; m < 16; ++m) {
        const int sl = m >> 2, db = m & 3;
        o[db] = __builtin_amdgcn_mfma_f32_32x32x16_bf16(vf[m % 5], __builtin_bit_cast(bf16x8, pwv[sl]), o[db], 0, 0, 0);
        if (m + 5 < 16) vf[m % 5] = FA_VF(m + 5);
        if (m == 11) { if constexpr (HAS_NEXT) { if (edge_next) edge_mask(n0, n1, -1, lim_hi_next, hi); mx = rowmax32(n0, n1); FA_PIN(mx); } }
        if (m == 9 || m == 11 || m == 15) __builtin_amdgcn_sched_barrier(0);
    }
#undef FA_VF
    if constexpr (HAS_NEXT) {
        const bool cond = mx > FA_THR;
        if (__any(cond)) {
            const float dl = cond ? mx : 0.f, nm = st.negm[0] - dl; st.alpha = ex2(-dl); st.l *= st.alpha;
#pragma unroll
            for (int r = 0; r < 16; ++r) { n0[r] -= dl; n1[r] -= dl; st.negm[r] = nm; }
        }
    }
}
#undef KFRAG
}
__device__ __forceinline__ void diff_attn_pipe(Frame& F, const bf16* Q, const bf16* K, const bf16* V, bf16* ATT, float lam, float lambda_init, const float* subln) {
    using namespace fa;
    const int wave = F.wave, c = wave >> 2, w = wave & 3;
    LAS unsigned char* L = F.lds;
    LAS float* SGL = (LAS float*)(L + 131072);
    if (F.tid < 128) SGL[F.tid] = subln[F.tid];
    for (int slot = F.vcu; slot < 256; slot += F.G)
        for (int i = 0; i < 8; ++i) {
            int lane_ = F.lane; asm volatile("" : "+v"(lane_));
            const int lane = lane_, r32 = lane & 31, hi = lane >> 5;
            const int kk_ = wave * 8 + (lane >> 3);
            const unsigned voffK = (unsigned)(kk_ * 64 + (((lane & 7) ^ ((kk_ >> 1) & 7)) * 8)) * 2u;
            const unsigned voffV0 = (unsigned)((16 * (wave & 3) + (lane >> 2)) * 128 + 32 * (wave >> 2) + 8 * (lane & 3)) * 2u, voffV1 = voffV0 + 64u * 2u;
            const int bh = (slot >> 5) * 8 + (i >> 1) * 2 + ((slot >> 4) & 1), pq = slot & 15, qb = (i & 1) ? 31 - pq : pq, b = bh >> 3, h = bh & 7;
            const int t = qb * 128 + w * 32 + r32;
            int lq = lane; asm volatile("" : "+v"(lq));
            const bf16* Qp = Q + ((size_t)(b * 16 + h * 2 + c) * SEQ + qb * 128 + w * 32 + (lq & 31)) * 64 + (lq >> 5) * 8;
            bf16x8 qr[4];
#pragma unroll
            for (int d0 = 0; d0 < 4; ++d0) qr[d0] = *(const bf16x8*)(Qp + d0 * 16);
            asm volatile("" : "+v"(qr[0]), "+v"(qr[1]), "+v"(qr[2]), "+v"(qr[3]));
            const bf16* K0 = K + (size_t)(b * 16 + h * 2) * SEQ * 64; const bf16* K1 = K0 + (size_t)SEQ * 64; const bf16* Vb = V + (size_t)(b * 8 + h) * SEQ * 128;
            const int nt = 2 * qb + 2;
            f32x16 o[4]; PipeState st; st.l = 0.f; st.alpha = 1.f;
#pragma unroll
            for (int db = 0; db < 4; ++db)
#pragma unroll
                for (int r = 0; r < 16; ++r) o[db][r] = 0.f;
#define DIFF_STAGE(j, buf) do { LAS unsigned char* B_ = L + (buf) * 32768; \
                dma16s(K0 + (size_t)(j) * 4096, voffK, B_ + wave * 1024); dma16s(K1 + (size_t)(j) * 4096, voffK, B_ + 8192 + wave * 1024); \
                dma16s(Vb + (size_t)(j) * 8192, voffV0, B_ + 16384 + wave * 1024); dma16s(Vb + (size_t)(j) * 8192, voffV1, B_ + 16384 + (wave + 8) * 1024); } while (0)
            for (int jj = 0; jj < 3 && jj < nt; ++jj) DIFF_STAGE(jj, jj);
            FA_RINGBAR4(nt - 1);
            f32x16 sa0, sa1, sb0, sb1;
            {
                scores(L + c * 8192, qr, sa0, sa1, lane);
                if (nt == 2) edge_mask(sa0, sa1, -1, t, hi);
                const float mx = rowmax32(sa0, sa1);
#pragma unroll
                for (int r = 0; r < 16; ++r) { sa0[r] -= mx; sa1[r] -= mx; st.negm[r] = -mx; }
            }
            for (int j = 0; j < nt - 2; j += 2) {
                FA_RINGBAR4(1);
                if (j + 3 < nt) DIFF_STAGE(j + 3, (j + 3) & 3);
                diff_step<true>(L + ((j + 1) & 3) * 32768 + c * 8192, L + (j & 3) * 32768 + 16384, qr, sa0, sa1, sb0, sb1, st, o, j + 1 >= nt - 2, t - (j + 1) * 64, lane);
                FA_RINGBAR4((nt - 2 - j >= 2) ? 1 : 0);
                if (j + 4 < nt) DIFF_STAGE(j + 4, (j + 4) & 3);
                diff_step<true>(L + ((j + 2) & 3) * 32768 + c * 8192, L + ((j + 1) & 3) * 32768 + 16384, qr, sb0, sb1, sa0, sa1, st, o, j + 2 >= nt - 2, t - (j + 2) * 64, lane);
            }
            {
                const int j = nt - 2;
                FA_RINGBAR4(0);
                diff_step<true>(L + ((j + 1) & 3) * 32768 + c * 8192, L + (j & 3) * 32768 + 16384, qr, sa0, sa1, sb0, sb1, st, o, true, t - (j + 1) * 64, lane);
                diff_step<false>(L, L + ((j + 1) & 3) * 32768 + 16384, qr, sb0, sb1, sa0, sa1, st, o, false, 0, lane);
            }
#undef DIFF_STAGE
            FA_WAITBAR();
            if (__any(st.alpha != 1.0f)) {
#pragma unroll
                for (int db = 0; db < 4; ++db)
#pragma unroll
                    for (int r = 0; r < 16; ++r) o[db][r] *= st.alpha;
            }
            const float inv = 1.0f / xsum(st.l);
            int le = lane; asm volatile("" : "+v"(le));
            const int hie = le >> 5, te = qb * 128 + w * 32 + (le & 31);
            LAS float* X = (LAS float*)L + (size_t)(w * 64) * 64 + le;
            if (c == 1) {
#pragma unroll
                for (int db = 0; db < 4; ++db)
#pragma unroll
                    for (int r = 0; r < 16; ++r) X[(db * 16 + r) * 64] = o[db][r] * inv * lam;
            }
            FA_WAITBAR();
            if (c == 0) {
                float ss = 0.f;
#pragma unroll
                for (int db = 0; db < 4; ++db)
#pragma unroll
                    for (int r = 0; r < 16; ++r) { const float a = o[db][r] * inv - X[(db * 16 + r) * 64]; o[db][r] = a; ss += a * a; }
                ss = xsum(ss);
                const float rr = __builtin_amdgcn_rsqf(ss * (1.0f / 128.0f) + 1e-5f) * (1.0f - lambda_init);
                bf16* rowp = ATT + (size_t)(b * SEQ + te) * D + h * 128;
                typedef unsigned u2 __attribute__((ext_vector_type(2)));
#pragma unroll
                for (int db = 0; db < 4; ++db)
#pragma unroll
                    for (int rq = 0; rq < 4; ++rq) { const f32x4 sg = *(const LAS f32x4*)(SGL + 32 * db + 8 * rq + 4 * hie);
                        u2 wv; wv.x = cvtpk(o[db][4 * rq] * rr * sg[0], o[db][4 * rq + 1] * rr * sg[1]); wv.y = cvtpk(o[db][4 * rq + 2] * rr * sg[2], o[db][4 * rq + 3] * rr * sg[3]);
                        *(u2*)(rowp + 32 * db + 8 * rq + 4 * hie) = wv; }
            }
            FA_WAITBAR();
        }
}

__device__ __forceinline__ void moba_attn_fast(Frame& F, const bf16* Q, const bf16* K, const bf16* V, const float* KM, bf16* ATT) {
    using namespace fa;
    int lane_ = F.lane; asm volatile("" : "+v"(lane_));
    const int lane = lane_, wave = F.wave, r32 = lane & 31, hi = lane >> 5;
    LAS unsigned char* L = F.lds;
    LAS unsigned* bitsL = (LAS unsigned*)(L + 65536);
    LAS int* TL = (LAS int*)(L + 65536 + 2048);
    for (int slot = F.vcu; slot < 256; slot += F.G)
        for (int i = 0; i < 8; ++i) {
            const int bh = (slot >> 2) * 2 + (i >> 2), qd = slot & 3, i4 = i & 3, cb = i4 == 0 ? qd : (i4 == 1 ? 15 - qd : (i4 == 2 ? 8 + qd : 7 - qd)), b = bh >> 4, h = bh & 15;
            const bf16* Qb = Q + (size_t)(b * 16 + h) * SEQ * 64; const bf16* Kb = K + (size_t)(b * 16 + h) * SEQ * 64; const bf16* Vb = V + (size_t)(b * 16 + h) * SEQ * 64;
            if (F.tid == 0) bitsL[256] = 0u;
            FA_WAITBAR();
            if (F.tid < 256) {
                unsigned bits = 0u;
                if (cb <= 3) bits = (1u << cb) - 1u;
                else {
                    float q[64]; load_row64(Qb + (size_t)(cb * 256 + F.tid) * 64, q);
                    const float* km = KM + (size_t)(b * 16 + h) * 16 * 64;
                    float v1 = -INFINITY, v2 = -INFINITY, v3 = -INFINITY; int i1 = 0, i2 = 0, i3 = 0;
                    for (int n = 0; n < cb; ++n) {
                        float g0 = 0.f, g1 = 0.f;
#pragma unroll
                        for (int d = 0; d < 64; d += 2) { g0 += q[d] * km[n * 64 + d]; g1 += q[d + 1] * km[n * 64 + d + 1]; }
                        const float g = g0 + g1;
                        if (g > v1) { v3 = v2; i3 = i2; v2 = v1; i2 = i1; v1 = g; i1 = n; }
                        else if (g > v2) { v3 = v2; i3 = i2; v2 = g; i2 = n; }
                        else if (g > v3) { v3 = g; i3 = n; }
                    }
                    bits = (1u << i1) | (1u << i2) | (1u << i3);
                }
                bitsL[F.tid] = bits;
                __hip_atomic_fetch_or(&bitsL[256], bits, __ATOMIC_RELAXED, __HIP_MEMORY_SCOPE_WORKGROUP);
            }
            FA_WAITBAR();
            const unsigned mybits = bitsL[wave * 32 + r32];
            const unsigned umask = (unsigned)__builtin_amdgcn_readfirstlane(bitsL[256]) | (1u << cb);
            const int nt = 4 * __builtin_popcount(umask);
            if (wave == 0) { const int blk = lane >> 2; if ((umask >> blk) & 1u) TL[4 * __builtin_popcount(umask & ((1u << blk) - 1u)) + (lane & 3)] = lane; }
            FA_WAITBAR();
            const int t = cb * 256 + wave * 32 + r32;
            const bf16* Qp = Qb + (size_t)t * 64 + hi * 8;
            bf16x8 qr[4];
#pragma unroll
            for (int d0 = 0; d0 < 4; ++d0) qr[d0] = *(const bf16x8*)(Qp + d0 * 16);
            asm volatile("" : "+v"(qr[0]), "+v"(qr[1]), "+v"(qr[2]), "+v"(qr[3]));
            f32x16 o[2]; RowState st; row_init(st);
#pragma unroll
            for (int db = 0; db < 2; ++db)
#pragma unroll
                for (int r = 0; r < 16; ++r) o[db][r] = 0.f;
#define MOBA_STAGE(tile, buf) do { LAS unsigned char* B_ = L + (buf) * 16384; stage_k64(Kb + (size_t)(tile) * 4096, B_, wave, lane); stage_v64(Vb + (size_t)(tile) * 4096, B_ + 8192, wave, lane); } while (0)
            for (int jj = 0; jj < 3 && jj < nt; ++jj) MOBA_STAGE(__builtin_amdgcn_readfirstlane(TL[jj]), jj);
            for (int j = 0; j < nt; ++j) {
                const int ahead = nt - 1 - j;
                FA_RINGBAR2(ahead);
                if (j + 3 < nt) MOBA_STAGE(__builtin_amdgcn_readfirstlane(TL[j + 3]), (j + 3) & 3);
                const int tile = __builtin_amdgcn_readfirstlane(TL[j]), n_cur = tile >> 2, tt = tile & 3;
                const LAS unsigned char* B = L + (j & 3) * 16384;
                {
                    const bool past = n_cur < cb, sel = past ? ((mybits >> n_cur) & 1u) != 0u : true;
                    const int wq = wave >> 1;
                    const bool active = past ? (bool)__any(sel) : (tt <= wq), use_keep = past && !__all(sel), edge = !past && tt == wq;
                    if (active) attn_tile<2>(B, B + 8192, qr, st, o, edge, -1, wave * 32 + r32 - tt * 64, use_keep, sel, lane);
                }
            }
#undef MOBA_STAGE
            store_ot<2>(ATT + (size_t)(b * SEQ + t) * D + h * 64, o, 1.0f / xsum(st.l), hi);
            FA_WAITBAR();
        }
}

__device__ __forceinline__ void moba_attn_fast2(Frame& F, const bf16* Q, const bf16* K, const bf16* V, const float* KM, bf16* ATT) {
    using namespace fa;
    int lane_ = F.lane; asm volatile("" : "+v"(lane_));
    const int lane = lane_, wave = F.wave, r32 = lane & 31, hi = lane >> 5, w4 = wave & 3;
    LAS unsigned char* L = F.lds;
    LAS unsigned* bitsL = (LAS unsigned*)(L + 65536);
    LAS int* TL = (LAS int*)(L + 65536 + 4096);
    for (int slot = F.vcu; slot < 256; slot += F.G)
        for (int i = 0; i < 4; ++i) {
            const int bh = (slot >> 5) * 16 + i * 4 + ((slot >> 3) & 3), pp = (i & 1) ? 7 - (slot & 7) : (slot & 7), cb0 = 2 * pp, cbw = cb0 + (wave >> 2), b = bh >> 4, h = bh & 15;
            const bf16* Qb = Q + (size_t)(b * 16 + h) * SEQ * 64; const bf16* Kb = K + (size_t)(b * 16 + h) * SEQ * 64; const bf16* Vb = V + (size_t)(b * 16 + h) * SEQ * 64;
            LAS float* KML = (LAS float*)(L + 65536 + 8192);
            { const float* km = KM + (size_t)(b * 16 + h) * 16 * 64; KML[F.tid] = km[F.tid]; KML[512 + F.tid] = km[512 + F.tid]; }
            if (F.tid == 0) bitsL[512] = 0u;
            FA_WAITBAR();
            {
                unsigned bits = 0u;
                if (cbw <= 3) bits = (1u << cbw) - 1u;
                else {
                    float q[64]; load_row64(Qb + (size_t)(cb0 * 256 + F.tid) * 64, q);
                    float v1 = -INFINITY, v2 = -INFINITY, v3 = -INFINITY; int i1 = 0, i2 = 0, i3 = 0;
                    for (int n = 0; n < cbw; ++n) {
                        const LAS f32x4* kr = (const LAS f32x4*)(KML + n * 64);
                        float g0 = 0.f, g1 = 0.f;
#pragma unroll
                        for (int d4 = 0; d4 < 16; ++d4) { const f32x4 kv = kr[d4]; g0 += q[4 * d4] * kv[0]; g1 += q[4 * d4 + 1] * kv[1]; g0 += q[4 * d4 + 2] * kv[2]; g1 += q[4 * d4 + 3] * kv[3]; }
                        const float g = g0 + g1;
                        if (g > v1) { v3 = v2; i3 = i2; v2 = v1; i2 = i1; v1 = g; i1 = n; }
                        else if (g > v2) { v3 = v2; i3 = i2; v2 = g; i2 = n; }
                        else if (g > v3) { v3 = g; i3 = n; }
                    }
                    bits = (1u << i1) | (1u << i2) | (1u << i3);
                }
                bitsL[F.tid] = bits;
                unsigned wb = bits;
#pragma unroll
                for (int off = 1; off < 64; off <<= 1) wb |= (unsigned)__shfl_xor((int)wb, off);
                if (lane == 0) __hip_atomic_fetch_or(&bitsL[512], wb, __ATOMIC_RELAXED, __HIP_MEMORY_SCOPE_WORKGROUP);
            }
            FA_WAITBAR();
            const unsigned bitsA = bitsL[wave * 64 + r32], bitsB = bitsL[wave * 64 + 32 + r32];
            const unsigned umask = (unsigned)__builtin_amdgcn_readfirstlane(bitsL[512]) | (3u << cb0);
            const int nt = 4 * __builtin_popcount(umask);
            if (wave == 0) { const int blk = lane >> 2; if ((umask >> blk) & 1u) TL[4 * __builtin_popcount(umask & ((1u << blk) - 1u)) + (lane & 3)] = lane; }
            FA_WAITBAR();
            const int tA = cbw * 256 + w4 * 64 + r32, tB = tA + 32;
            bf16x8 qa[4], qb[4];
#pragma unroll
            for (int d0 = 0; d0 < 4; ++d0) { qa[d0] = *(const bf16x8*)(Qb + (size_t)tA * 64 + hi * 8 + d0 * 16); qb[d0] = *(const bf16x8*)(Qb + (size_t)tB * 64 + hi * 8 + d0 * 16); }
            asm volatile("" : "+v"(qa[0]), "+v"(qa[1]), "+v"(qa[2]), "+v"(qa[3]), "+v"(qb[0]), "+v"(qb[1]), "+v"(qb[2]), "+v"(qb[3]));
            f32x16 oa[2], ob[2]; RowState2 sa, sb; row_init2(sa); row_init2(sb);
#pragma unroll
            for (int db = 0; db < 2; ++db)
#pragma unroll
                for (int r = 0; r < 16; ++r) { oa[db][r] = 0.f; ob[db][r] = 0.f; }
#define MOBA_STAGE(tile, buf) do { LAS unsigned char* B_ = L + (buf) * 16384; stage_k64(Kb + (size_t)(tile) * 4096, B_, wave, lane); stage_v64(Vb + (size_t)(tile) * 4096, B_ + 8192, wave, lane); } while (0)
            for (int jj = 0; jj < 3 && jj < nt; ++jj) MOBA_STAGE(__builtin_amdgcn_readfirstlane(TL[jj]), jj);
            for (int j = 0; j < nt; ++j) {
                const int ahead = nt - 1 - j;
                FA_RINGBAR2(ahead);
                int lane = lane_; asm volatile("" : "+v"(lane));
                const int r32 = lane & 31;
                if (j + 3 < nt) MOBA_STAGE(__builtin_amdgcn_readfirstlane(TL[j + 3]), (j + 3) & 3);
                const int tile = __builtin_amdgcn_readfirstlane(TL[j]), n_cur = tile >> 2, tt = tile & 3;
                const LAS unsigned char* B = L + (j & 3) * 16384;
                const bool past = n_cur < cbw, own = n_cur == cbw;
                const bool selA = past ? ((bitsA >> n_cur) & 1u) != 0u : true, selB = past ? ((bitsB >> n_cur) & 1u) != 0u : true;
                const bool active = past ? (bool)__any(selA || selB) : (own && tt <= w4), edge = own && tt == w4;
                if (active) {
                    bf16x8 pa[4], pb[4];
                    { f32x16 p0, p1, c; const float c1 = selA ? -sa.mref : -INFINITY;
#pragma unroll
                      for (int r = 0; r < 16; ++r) c[r] = c1;
                      scores_c(B, qa, c, p0, p1, lane); softmax_pack<2>(p0, p1, sa, oa, pa, edge, -1, r32, lane); }
                    __builtin_amdgcn_sched_barrier(0);
                    { f32x16 p0, p1, c; const float c1 = selB ? -sb.mref : -INFINITY;
#pragma unroll
                      for (int r = 0; r < 16; ++r) c[r] = c1;
                      scores_c(B, qb, c, p0, p1, lane); softmax_pack<2>(p0, p1, sb, ob, pb, edge, -1, 32 + r32, lane); }
                    __builtin_amdgcn_sched_barrier(0);
                    pv2(B + 8192, pa, pb, oa, ob, lane);
                }
            }
#undef MOBA_STAGE
            store_ot<2>(ATT + (size_t)(b * SEQ + tA) * D + h * 64, oa, 1.0f / xsum(sa.l), hi);
            store_ot<2>(ATT + (size_t)(b * SEQ + tB) * D + h * 64, ob, 1.0f / xsum(sb.l), hi);
            FA_WAITBAR();
        }
}

__device__ __forceinline__ void nsa_attn_fast(Frame& F, const bf16* Q, const bf16* KVC, const bf16* KS, const bf16* VS, const bf16* KW, const bf16* VW, const float* GATE, bf16* ATT) {
    using namespace fa;
    const int wave = F.wave, hd = wave >> 1, qh = wave & 1;
    LAS unsigned char* L = F.lds;
    LAS float* IMP = (LAS float*)(L + 65536);
    LAS unsigned long long* SELL = (LAS unsigned long long*)(L + 65536 + 66560);
    LAS int* TL = (LAS int*)(L + 65536 + 66560 + 512);
    for (int slot = F.vcu; slot < 256; slot += F.G)
        for (int i = 0; i < 8; ++i) {
            int lane_ = F.lane; asm volatile("" : "+v"(lane_));
            const int lane = lane_, r32 = lane & 31, hi = lane >> 5;
            const int bg = (slot >> 5) * 4 + (i >> 1), pq = slot & 31, qblk = (i & 1) ? 63 - pq : pq, b = bg >> 2, g = bg & 3, head = g * 4 + hd;
            const int trel = qh * 32 + r32, t = qblk * 64 + trel;
            const bf16* Qp = Q + ((size_t)(b * 16 + head) * SEQ + t) * 64 + hi * 8;
            bf16x8 qr[4];
#pragma unroll
            for (int d0 = 0; d0 < 4; ++d0) qr[d0] = *(const bf16x8*)(Qp + d0 * 16);
            asm volatile("" : "+v"(qr[0]), "+v"(qr[1]), "+v"(qr[2]), "+v"(qr[3]));
            const float* gt = GATE + (size_t)(b * SEQ + t) * 48 + head * 3; float g0 = gt[0], g1 = gt[1], g2 = gt[2]; asm volatile("" : "+v"(g0), "+v"(g1), "+v"(g2));
            f32x16 ot[2], o[2];
#pragma unroll
            for (int db = 0; db < 2; ++db)
#pragma unroll
                for (int r = 0; r < 16; ++r) { ot[db][r] = 0.f; o[db][r] = 0.f; }
            for (int e = F.tid; e < 4 * 64 * 65; e += 512) IMP[e] = 0.f;
            const bf16* kc = KVC + (size_t)(b * 4 + g) * 256 * 64; const bf16* vc = kc + (size_t)BATCH * 4 * 256 * 64;
            const int nmax = t >= 31 ? (((t - 31) >> 4) < 254 ? ((t - 31) >> 4) : 254) : -1;
            const int numax = ((qblk * 64 + 32) >> 4) < 254 ? ((qblk * 64 + 32) >> 4) : 254;
            const int ntc = (numax >> 6) + 1;
            float m = -INFINITY, l = 0.f;
#define CMP_STAGE(tile, buf) do { LAS unsigned char* B_ = L + (buf) * 16384; stage_k64(kc + (size_t)(tile) * 4096, B_, wave, lane); stage_v64(vc + (size_t)(tile) * 4096, B_ + 8192, wave, lane); } while (0)
            for (int j = 0; j < ntc; ++j) CMP_STAGE(j, j);
            FA_WAITBAR();
            for (int j = 0; j < ntc; ++j) {
                const LAS unsigned char* B = L + j * 16384;
                f32x16 p0, p1; scores(B, qr, p0, p1, lane);
                if (__any(nmax - j * 64 < 63)) edge_mask(p0, p1, -1, nmax - j * 64, hi);
                const float mn = fmaxf(m, rowmax32(p0, p1)), mref = (mn == -INFINITY) ? 0.f : mn;
                float ps = 0.f;
#pragma unroll
                for (int r = 0; r < 16; ++r) ps += ex2(p0[r] - mref) + ex2(p1[r] - mref);
                l = l * ex2(m - mref) + ps; m = mn;
            }
            {
                const float lt = xsum(l), il = lt > 0.f ? 1.0f / lt : 0.f, mref = (m == -INFINITY) ? 0.f : m;
                LAS float* imp = IMP + (size_t)(hd * 64 + trel) * 65; float carry = 0.f;
                for (int j = 0; j < ntc; ++j) {
                    const LAS unsigned char* B = L + j * 16384;
                    f32x16 p0, p1; scores(B, qr, p0, p1, lane);
                    if (__any(nmax - j * 64 < 63)) edge_mask(p0, p1, -1, nmax - j * 64, hi);
#pragma unroll
                    for (int r = 0; r < 16; ++r) { p0[r] = ex2(p0[r] - mref) * il; p1[r] = ex2(p1[r] - mref) * il; }
                    float q0[4], q1[4];
#pragma unroll
                    for (int a = 0; a < 4; ++a) {
                        auto r0 = __builtin_amdgcn_permlane32_swap(__float_as_uint(p0[4 * a + 3]), __float_as_uint(p0[4 * a + 3]), false, false);
                        auto r1 = __builtin_amdgcn_permlane32_swap(__float_as_uint(p1[4 * a + 3]), __float_as_uint(p1[4 * a + 3]), false, false);
                        q0[a] = __uint_as_float(hi ? r0[0] : r0[1]); q1[a] = __uint_as_float(hi ? r1[0] : r1[1]);
                    }
#pragma unroll
                    for (int a = 0; a < 4; ++a) {
                        const float cin0 = hi ? q0[a] : (a ? q0[a > 0 ? a - 1 : 0] : carry), cin1 = hi ? q1[a] : (a ? q1[a > 0 ? a - 1 : 0] : q0[3]);
                        imp[16 * j + 2 * a + hi] = ((p0[4 * a] + p0[4 * a + 1]) + (p0[4 * a + 2] + p0[4 * a + 3])) + cin0;
                        imp[16 * j + 8 + 2 * a + hi] = ((p1[4 * a] + p1[4 * a + 1]) + (p1[4 * a + 2] + p1[4 * a + 3])) + cin1;
                    }
                    carry = q1[3];
                    bf16x8 pw[4]; pack_p(p0, p1, pw);
                    pv<2>(B + 8192, pw, o, lane);
                }
#pragma unroll
                for (int db = 0; db < 2; ++db)
#pragma unroll
                    for (int r = 0; r < 16; ++r) { ot[db][r] = g0 * o[db][r]; o[db][r] = 0.f; }
            }
#undef CMP_STAGE
            FA_WAITBAR();
#pragma unroll 1
            for (int rr = 0; rr < 8; ++rr) {
                const int row = wave * 8 + rr;
                bool sel;
                if (qblk < 16) sel = lane <= qblk;
                else {
                    const float v = (IMP[(size_t)(0 * 64 + row) * 65 + lane] + IMP[(size_t)(1 * 64 + row) * 65 + lane]) + (IMP[(size_t)(2 * 64 + row) * 65 + lane] + IMP[(size_t)(3 * 64 + row) * 65 + lane]);
                    asm volatile("" ::: "memory");
                    IMP[(size_t)row * 65 + lane] = v;
                    asm volatile("s_waitcnt lgkmcnt(0)" ::: "memory");
                    const bool cand = lane >= 1 && lane <= qblk - 2;
                    int rank = 0;
                    const LAS float* ir = IMP + (size_t)row * 65;
#pragma unroll 1
                    for (int k0 = 1; k0 <= qblk - 2; k0 += 16) {
                        float vk[16];
#pragma unroll
                        for (int u = 0; u < 16; ++u) vk[u] = ir[k0 + u];
                        asm volatile("s_waitcnt lgkmcnt(0)" ::: "memory");
#pragma unroll
                        for (int u = 0; u < 16; ++u) { const int k = k0 + u; const float x = k <= qblk - 2 ? vk[u] : -INFINITY; rank += (x > v || (x == v && k < lane)) ? 1 : 0; }
                    }
                    sel = lane == 0 || lane == qblk || lane == qblk - 1 || (cand && rank < 13);
                }
                const unsigned long long mk = __ballot(sel);
                if (lane == 0) SELL[row] = mk;
            }
            FA_WAITBAR();
            const unsigned long long mysel = SELL[trel];
            unsigned long long un = SELL[lane];
#pragma unroll
            for (int off = 1; off < 64; off <<= 1) { const unsigned lo_ = __shfl_xor((unsigned)un, off), hi_ = __shfl_xor((unsigned)(un >> 32), off); un |= ((unsigned long long)hi_ << 32) | lo_; }
            const unsigned long long umask = ((unsigned long long)(unsigned)__builtin_amdgcn_readfirstlane((unsigned)(un >> 32)) << 32) | (unsigned)__builtin_amdgcn_readfirstlane((unsigned)un);
            const int nts = __builtin_popcountll(umask);
            if (wave == 0) { if ((umask >> lane) & 1ull) TL[__builtin_popcountll(umask & ((1ull << lane) - 1ull))] = lane; }
            FA_WAITBAR();
            {
                const bf16* kb = KS + (size_t)(b * 4 + g) * SEQ * 64; const bf16* vb = VS + (size_t)(b * 4 + g) * SEQ * 64;
#define SEL_STAGE(tile, buf) do { LAS unsigned char* B_ = L + (buf) * 16384; stage_k64(kb + (size_t)(tile) * 4096, B_, wave, lane); stage_v64(vb + (size_t)(tile) * 4096, B_ + 8192, wave, lane); } while (0)
                RowState st; row_init(st);
                for (int jj = 0; jj < 3 && jj < nts; ++jj) SEL_STAGE(__builtin_amdgcn_readfirstlane(TL[jj]), jj);
                for (int j = 0; j < nts; ++j) {
                    const int ahead = nts - 1 - j;
                    FA_RINGBAR2(ahead);
                    if (j + 3 < nts) SEL_STAGE(__builtin_amdgcn_readfirstlane(TL[j + 3]), (j + 3) & 3);
                    const int j_cur = __builtin_amdgcn_readfirstlane(TL[j]);
                    const LAS unsigned char* B = L + (j & 3) * 16384;
                    const bool sel = (mysel >> j_cur) & 1ull;
                    {
                        const bool diag = j_cur == qblk, active = diag || __any(sel), use_keep = !__all(sel);
                        if (active) attn_tile<2>(B, B + 8192, qr, st, o, diag, -1, trel, use_keep, sel, lane);
                    }
                }
#undef SEL_STAGE
                const float lt = xsum(st.l), w1 = lt > 0.f ? g1 / lt : 0.f;
#pragma unroll
                for (int db = 0; db < 2; ++db)
#pragma unroll
                    for (int r = 0; r < 16; ++r) { ot[db][r] += w1 * o[db][r]; o[db][r] = 0.f; }
            }
            FA_WAITBAR();
            {
                const bf16* kb = KW + (size_t)(b * 4 + g) * SEQ * 64; const bf16* vb = VW + (size_t)(b * 4 + g) * SEQ * 64;
#define WIN_STAGE(tile, buf) do { LAS unsigned char* B_ = L + (buf) * 16384; stage_k64(kb + (size_t)(tile) * 4096, B_, wave, lane); stage_v64(vb + (size_t)(tile) * 4096, B_ + 8192, wave, lane); } while (0)
                RowState st; row_init(st);
                const int jlo = qblk >= 8 ? qblk - 8 : 0;
                const int ntw = qblk - jlo + 1;
                for (int jj = 0; jj < 3 && jj < ntw; ++jj) WIN_STAGE(jlo + jj, jj);
                for (int jw = 0; jw < ntw; ++jw) {
                    const int ahead = ntw - 1 - jw, j = jlo + jw;
                    FA_RINGBAR2(ahead);
                    if (jw + 3 < ntw) WIN_STAGE(j + 3, (jw + 3) & 3);
                    const LAS unsigned char* B = L + (jw & 3) * 16384;
                    attn_tile<2>(B, B + 8192, qr, st, o, j == qblk || j == qblk - 8, j == qblk - 8 ? trel : -1, j == qblk ? trel : 63, false, true, lane);
                }
#undef WIN_STAGE
                const float lt = xsum(st.l), w2 = lt > 0.f ? g2 / lt : 0.f;
#pragma unroll
                for (int db = 0; db < 2; ++db)
#pragma unroll
                    for (int r = 0; r < 16; ++r) ot[db][r] += w2 * o[db][r];
            }
            store_ot<2>(ATT + (size_t)(b * SEQ + t) * D + head * 64, ot, 1.0f, hi);
            FA_WAITBAR();
        }
}

constexpr unsigned I8_INPROJ_MASK = 0xFu;
constexpr unsigned F8_DOWN_MASK = 0xF8u;
__device__ __forceinline__ void weights_absmax(Frame& F) {
    LAS float* red = (LAS float*)F.lds;
    for (int item = blockIdx.x; item < 8 * 22 + 4 * 12; item += F.G) {
        const float* W; const float* g; int N, cg, ffn; float* SW; float* SWI;
        if (item < 8 * 22) { const int i = item / 22; cg = item % 22; ffn = 1; N = 2 * DFF; W = F.in[2] + (size_t)i * D * 2 * DFF; g = F.in[1] + (size_t)((i >> 1) * 6 + (i & 1) * 4) * D;
            SW = (float*)(F.ws + TAB_SW) + i * (2 * DFF); SWI = (float*)(F.ws + TAB_SWI) + i * (2 * DFF); }
        else { const int L = (item - 8 * 22) / 12; cg = (item - 8 * 22) % 12; ffn = 0; g = F.in[1] + (size_t)(L * 6 + 2) * D;
            if (L == 1) { W = F.in[8]; N = 3072; } else if (L == 2) { W = F.in[10]; N = NSA_IN; } else { W = F.in[4] + (size_t)(L / 3) * D * 3072; N = 3072; }
            SW = (float*)(F.ws + TAB_SW2) + L * 3072; SWI = (float*)(F.ws + TAB_SWI2) + L * 3072; }
        const int k0 = F.wave * 128, c4 = cg * 256 + 4 * F.lane;
        f32x4 m = {0.f, 0.f, 0.f, 0.f};
        if (c4 < N) {
            const float* Wp = W + (size_t)k0 * N + c4;
#pragma unroll 16
            for (int k = 0; k < 128; ++k) { const f32x4 v = *(const f32x4*)(Wp + (size_t)k * N) * g[k0 + k];
                m[0] = fmaxf(m[0], fabsf(v[0])); m[1] = fmaxf(m[1], fabsf(v[1])); m[2] = fmaxf(m[2], fabsf(v[2])); m[3] = fmaxf(m[3], fabsf(v[3])); }
        }
        *(LAS f32x4*)(red + F.wave * 256 + 4 * F.lane) = m;
        __syncthreads();
        if (F.tid < 256) {
            float a = red[F.tid];
#pragma unroll
            for (int w = 1; w < 8; ++w) a = fmaxf(a, red[w * 256 + F.tid]);
            const int n = cg * 256 + F.tid; int r = n;
            if (ffn) { const int up = n >= DFF ? 1 : 0, j = n - up * DFF; r = 256 * (j >> 7) + 128 * up + (j & 127); }
            SW[r] = a * (1.0f / 127.0f); SWI[r] = a > 0.f ? 127.0f / a : 0.f;
        }
        __syncthreads();
    }
    for (int i = 0; i < 8; ++i) {
        if (!((F8_DOWN_MASK >> i) & 1u)) continue;
        const f32x4* W4 = (const f32x4*)(F.in[3] + (size_t)i * DFF * D);
        float m = 0.f;
        for (int idx = blockIdx.x * 512 + F.tid; idx < DFF * D / 4; idx += F.G * 512) { const f32x4 v = W4[idx]; m = fmaxf(fmaxf(m, fmaxf(fabsf(v[0]), fabsf(v[1]))), fmaxf(fabsf(v[2]), fabsf(v[3]))); }
        m = wave_max(m);
        if (F.lane == 0) red[F.wave] = m;
        __syncthreads();
        if (F.tid == 0) { float a = red[0];
#pragma unroll
            for (int w = 1; w < 8; ++w) a = fmaxf(a, red[w]);
            __hip_atomic_fetch_max((unsigned*)(F.ws + WS_CTL) + CW_WOMAX + i, __float_as_uint(a), __ATOMIC_RELAXED, __HIP_MEMORY_SCOPE_AGENT); }
        __syncthreads();
    }
}
__device__ __forceinline__ void prologue(Frame& F) {
    unsigned char* ws = F.ws;
    int cbase = 0;
    for (int i = 0; i < 8; ++i) conv_matrix(F, cbase, F.in[2] + (size_t)i * D * 2 * DFF, D, 2 * DFF, 2 * DFF, (bf16*)(ws + W_FFN_IN + i * FFN_IN_BYTES), 1, F.in[1] + (size_t)((i >> 1) * 6 + (i & 1) * 4) * D, (const float*)(ws + TAB_SWI) + i * (2 * DFF));
    for (int i = 0; i < 8; ++i) conv_matrix(F, cbase, F.in[3] + (size_t)i * DFF * D, DFF, D, D, (bf16*)(ws + W_FFN_OUT + i * FFN_OUT_BYTES), 0, nullptr, nullptr, ((F8_DOWN_MASK >> i) & 1u) ? (const float*)(ws + WS_CTL) + CW_WOMAX + i : nullptr);
    for (int i = 0; i < 2; ++i) conv_matrix(F, cbase, F.in[4] + (size_t)i * D * 3072, D, 3072, 3072, (bf16*)(ws + W_DIFF_IN + i * 6 * MiB), 0, F.in[1] + (size_t)((i * 3) * 6 + 2) * D, ((I8_INPROJ_MASK >> (3 * i)) & 1u) ? (const float*)(ws + TAB_SWI2) + (3 * i) * 3072 : nullptr);
    for (int i = 0; i < 2; ++i) conv_matrix(F, cbase, F.in[5] + (size_t)i * D * D, D, D, D, (bf16*)(ws + W_DIFF_OUT + i * 2 * MiB), 0);
    conv_matrix(F, cbase, F.in[8], D, 3072, 3072, (bf16*)(ws + W_MOBA_IN), 0, F.in[1] + (size_t)(1 * 6 + 2) * D, ((I8_INPROJ_MASK >> 1) & 1u) ? (const float*)(ws + TAB_SWI2) + 1 * 3072 : nullptr);
    conv_matrix(F, cbase, F.in[9], D, D, D, (bf16*)(ws + W_MOBA_OUT), 0);
    conv_matrix(F, cbase, F.in[10], D, NSA_IN, NSA_IN_PAD, (bf16*)(ws + W_NSA_IN), 0, F.in[1] + (size_t)(2 * 6 + 2) * D, ((I8_INPROJ_MASK >> 2) & 1u) ? (const float*)(ws + TAB_SWI2) + 2 * 3072 : nullptr);
    conv_matrix(F, cbase, F.in[11], D, D, D, (bf16*)(ws + W_NSA_OUT), 0);
    for (int i = 0; i < 2; ++i) conv_matrix(F, cbase, F.in[13] + (size_t)i * 2048 * 256, 2048, 256, 256, (bf16*)(ws + W_CMP1) + (size_t)i * 256 * 2048, 0);
    for (int i = 0; i < 2; ++i) conv_matrix(F, cbase, F.in[14] + (size_t)i * 256 * 64, 256, 64, 256, (bf16*)(ws + W_CMP2) + (size_t)i * 256 * 256, 0);
    {
        const double invf[8] = {1.0, 0.19392274474868576, 0.03760603093086393, 0.007292664737217109, 0.001414213562373095, 0.0002742481756762073, 5.318295896944988e-05, 1.031338537721246e-05};
        float* cs = (float*)(ws + TAB_COS); float* sn = (float*)(ws + TAB_SIN);
        for (int e = blockIdx.x * 512 + F.tid; e < SEQ * 8; e += F.G * 512) {
            const int t = e >> 3, i = e & 7;
            double f = invf[0];
#pragma unroll
            for (int k = 1; k < 8; ++k) f = (i == k) ? invf[k] : f;
            const double ang = (double)t * f, TWO_PI = 6.283185307179586476925286766559;
            const double kk = __builtin_rint(ang / TWO_PI), r = ang - kk * TWO_PI, z = r * r;
            double ts = r, ss = r, tc = 1.0, sc = 1.0;
#pragma unroll
            for (int k = 1; k <= 14; ++k) { ts *= -z / (double)((2 * k) * (2 * k + 1)); ss += ts; tc *= -z / (double)((2 * k - 1) * (2 * k)); sc += tc; }
            cs[e] = (float)sc; sn[e] = (float)ss;
        }
    }
    for (int task = blockIdx.x; task < 256; task += F.G) {
        const int kv = task >> 7, cg = (task >> 5) & 3, kc = task & 31, k0 = kc * 64 + F.wave * 8;
        const float* pe = F.in[12] + (size_t)kv * 2048 + k0; const float* w1 = F.in[13] + (size_t)kv * 2048 * 256 + (size_t)k0 * 256 + cg * 64 + F.lane;
        float a = 0.f;
#pragma unroll
        for (int k = 0; k < 8; ++k) a += pe[k] * w1[(size_t)k * 256];
        LAS float* red = (LAS float*)(F.lds + 131072);
        red[F.wave * 64 + F.lane] = a;
        __syncthreads();
        if (F.wave == 0) { float s = 0.f;
#pragma unroll
            for (int w = 0; w < 8; ++w) s += red[w * 64 + F.lane];
            ((float*)(ws + TAB_CBP))[kc * 512 + kv * 256 + cg * 64 + F.lane] = s; }
        __syncthreads();
    }
    if (blockIdx.x == 0 && F.wave == 0) {
        for (int j = 0; j < 2; ++j) {
            const float* lm = F.in[6] + j * 256;
            const float s1 = wave_sum(lm[F.lane] * lm[64 + F.lane]), s2 = wave_sum(lm[128 + F.lane] * lm[192 + F.lane]);
            const float li = j == 0 ? 0.2f : 0.5560582041556406f;
            if (F.lane == 0) ((float*)(ws + TAB_LAM))[j] = ex2(s1 * 1.4426950408889634f) - ex2(s2 * 1.4426950408889634f) + li;
        }
    }
    rows_phase(F, F.in[0], nullptr, 0.f, nullptr, (bf16*)(ws + WS_XN), (float*)(ws + TAB_RSTD), nullptr);
}


template <int HS>
__device__ __forceinline__ void ffn_half(Frame& F, const XcdBarrier& bar) {
    constexpr int l = HS >> 1, idx = HS & 1;
    constexpr bool F8D = ((F8_DOWN_MASK >> HS) & 1u) != 0;
    unsigned char* ws = F.ws;
    bf16* XN = (bf16*)(ws + WS_XN); bf16* Y = (bf16*)(ws + WS_Y); bf16* U = (bf16*)(ws + WS_U);
    {
        pg8::Gemm g{(const bf16*)(ws + WS_H8), (const bf16*)(ws + W_FFN_IN + (size_t)HS * FFN_IN_BYTES), D / 2, D / 2}; pg8::StaticOrder S; S.init(NTOK, 2 * DFF, F.G, (int)blockIdx.x);
        pg8::EpiSwiGLU<true, F8D> E{U, DFF, (const float*)(ws + TAB_RS8), (const float*)(ws + TAB_SW) + HS * (2 * DFF)};
        pg8::gemm_phase<pg8::EpiSwiGLU<true, F8D>, pg8::StaticOrder, true, true, 1>(F.lds, g, S, E, F.tid);
    }
    phase_sync(F, bar);
    {
        pg8::StaticOrder S; S.init(NTOK, D, F.G, (int)blockIdx.x);
        if constexpr (F8D) {
            float* oscp = (float*)(ws + WS_CTL) + CW_WOMAX + 8 + HS;
            if (F.tid == 0) *oscp = ((const float*)(ws + WS_CTL))[CW_WOMAX + HS] * (1.0f / (W8_TOP * pg8::U8_SCALE));
            pg8::Gemm g{U, (const bf16*)(ws + W_FFN_OUT + (size_t)HS * FFN_OUT_BYTES), DFF / 2, DFF / 2};
            pg8::EpiPlain E{Y, D, oscp};
            pg8::gemm_phase<pg8::EpiPlain, pg8::StaticOrder, true, true, 2>(F.lds, g, S, E, F.tid);
        } else {
            pg8::Gemm g{U, (const bf16*)(ws + W_FFN_OUT + (size_t)HS * FFN_OUT_BYTES), DFF, DFF};
            pg8::EpiPlain E{Y, D, nullptr};
            pg8::gemm_phase<pg8::EpiPlain, pg8::StaticOrder, true, true>(F.lds, g, S, E, F.tid);
        }
    }
    phase_sync(F, bar);
    {
        const float* ng = F.in[1] + (size_t)l * 6 * D;
        rows_phase(F, nullptr, Y, 0.5f, ng + (idx ? 5 : 1) * D, XN, (float*)(ws + TAB_RSTD), HS == 2 * DEPTH - 1 ? F.out : nullptr);
    }
    phase_sync(F, bar);
}

template <int L>
__device__ __forceinline__ void mixer(Frame& F, const XcdBarrier& bar) {
    constexpr int kind = L % 3, j = L / 3;
    unsigned char* ws = F.ws;
    bf16* XN = (bf16*)(ws + WS_XN); bf16* Y = (bf16*)(ws + WS_Y); bf16* ATT = (bf16*)(ws + WS_ATT); bf16* U = (bf16*)(ws + WS_U);
    const float* cs = (const float*)(ws + TAB_COS); const float* sn = (const float*)(ws + TAB_SIN);
    if constexpr (kind == 2) {
        if (blockIdx.x == 0) { float s = 0.f; const float* cp = (const float*)(ws + TAB_CBP) + F.tid;
#pragma unroll
            for (int i = 0; i < 32; ++i) s += cp[i * 512];
            ((float*)(ws + TAB_CBIAS))[F.tid] = s; }
    }
    {
        const bf16* Win = (const bf16*)(ws + (kind == 0 ? W_DIFF_IN + (size_t)j * 6 * MiB : (kind == 1 ? W_MOBA_IN : W_NSA_IN)));
        constexpr bool I8 = ((I8_INPROJ_MASK >> L) & 1u) != 0;
        pg8::StaticOrder S; S.init(NTOK, kind == 2 ? (I8 ? 2560 : NSA_IN_PAD) : 3072, F.G, (int)blockIdx.x);
        if constexpr (I8) {
            pg8::Gemm g{(const bf16*)(ws + WS_H8), Win, D / 2, D / 2};
            pg8::EpiHeads<kind, true> E{U, (float*)(ws + WS_GATE), cs, sn, (const float*)(ws + TAB_RS8), (const float*)(ws + TAB_SW2) + L * 3072};
            pg8::gemm_phase<pg8::EpiHeads<kind, true>, pg8::StaticOrder, true, true, 1>(F.lds, g, S, E, F.tid);
        } else {
            pg8::Gemm g{XN, Win, D, D};
            pg8::EpiHeads<kind, false> E{U, (float*)(ws + WS_GATE), cs, sn, (const float*)(ws + TAB_RSTD), nullptr};
            pg8::gemm_phase<pg8::EpiHeads<kind, false>, pg8::StaticOrder, true, true>(F.lds, g, S, E, F.tid);
        }
    }
    phase_sync(F, bar);
    const bf16* Q = U; const bf16* K = U + (size_t)NTOK * 1024; const bf16* V = U + (size_t)2 * NTOK * 1024;
    if constexpr (kind == 0) {
        constexpr float li = L == 0 ? 0.2f : 0.5560582041556406f;
        DIFF_ATTN(F, Q, K, V, ATT, ((const float*)(ws + TAB_LAM))[j], li, F.in[7] + j * 128);
    } else if constexpr (kind == 1) {
        moba_kmean(F, K, (float*)(ws + TAB_KMEAN));
        phase_sync(F, bar);
        MOBA_ATTN(F, Q, K, V, (const float*)(ws + TAB_KMEAN), ATT);
    } else {
        const bf16* KC = U + (size_t)NTOK * 1024;
        const size_t KVT = (size_t)NTOK * 256;
        {
            pg8::Gemm g{KC, (const bf16*)(ws + W_CMP1), 1024, 2048}; pg8::CmpOrder S{F.G, (int)blockIdx.x};
            pg8::EpiCmp1 E{(bf16*)(ws + WS_CH), (const float*)(ws + TAB_CBIAS)};
            pg8::gemm_phase<pg8::EpiCmp1, pg8::CmpOrder, true, true>(F.lds, g, S, E, F.tid);
        }
        if constexpr (((I8_INPROJ_MASK >> L) & 1u) != 0) {
            const int off = F.G > 128 ? 64 : 0;
            pg8::Gemm g{(const bf16*)(ws + WS_H8), (const bf16*)(ws + W_NSA_IN), D / 2, D / 2}; pg8::TileOrder S{F.G - off, (int)blockIdx.x - off, 10};
            pg8::EpiHeads<2, true> E{U, (float*)(ws + WS_GATE), cs, sn, (const float*)(ws + TAB_RS8), (const float*)(ws + TAB_SW2) + L * 3072};
            pg8::gemm_phase<pg8::EpiHeads<2, true>, pg8::TileOrder, true, true, 1>(F.lds, g, S, E, F.tid);
        }
        phase_sync(F, bar);
        {
            pg8::Gemm g{(const bf16*)(ws + WS_CH), (const bf16*)(ws + W_CMP2), 256, 256}; pg8::CmpOrder S{F.G, (int)blockIdx.x};
            pg8::EpiCmp2 E{(bf16*)(ws + WS_KVC)};
            pg8::gemm_phase<pg8::EpiCmp2, pg8::CmpOrder, true, true>(F.lds, g, S, E, F.tid);
        }
        phase_sync(F, bar);
#if NSA_FAST
        nsa_attn_fast(F, Q, (const bf16*)(ws + WS_KVC), KC + 2 * KVT, KC + 3 * KVT, KC + 4 * KVT, KC + 5 * KVT, (const float*)(ws + WS_GATE), ATT);
#else
        nsa_select_slow(F, Q, (const bf16*)(ws + WS_KVC), (unsigned long long*)(ws + WS_SEL));
        phase_sync(F, bar);
        nsa_attn_slow(F, Q, (const bf16*)(ws + WS_KVC), KC + 2 * KVT, KC + 3 * KVT, KC + 4 * KVT, KC + 5 * KVT, (const float*)(ws + WS_GATE), (const unsigned long long*)(ws + WS_SEL), ATT);
#endif
    }
    phase_sync(F, bar);
    {
        const bf16* Wout = (const bf16*)(ws + (kind == 0 ? W_DIFF_OUT + (size_t)j * 2 * MiB : (kind == 1 ? W_MOBA_OUT : W_NSA_OUT)));
        pg8::Gemm g{ATT, Wout, D, D}; pg8::StaticOrder S; S.init(NTOK, D, F.G, (int)blockIdx.x);
        pg8::EpiPlain E{Y, D, nullptr};
        pg8::gemm_phase<pg8::EpiPlain, pg8::StaticOrder, true, true>(F.lds, g, S, E, F.tid);
    }
    phase_sync(F, bar);
    {
        const float* ng = F.in[1] + (size_t)L * 6 * D;
        rows_phase(F, nullptr, Y, 1.0f, ng + 3 * D, XN, (float*)(ws + TAB_RSTD), nullptr);
    }
    phase_sync(F, bar);
}

__global__ void __launch_bounds__(NWAVES * 64, 2) fwd_kernel(Args args) {
    extern __shared__ __attribute__((aligned(16))) unsigned char lds[];
    Frame F;
    F.lds = (LAS unsigned char*)lds;
    F.MISC = (volatile LAS unsigned*)(F.lds + LDSCTL_OFF);
    F.tid = threadIdx.x; F.lane = F.tid & 63; F.wave = __builtin_amdgcn_readfirstlane(F.tid >> 6); F.G = gridDim.x; { const int bx = blockIdx.x; F.vcu = (F.G % 8 == 0) ? (bx % 8) * (F.G / 8) + bx / 8 : bx; }
    F.in.a = &args;
    F.out = args.out; F.ws = args.ws;
    for (int u = F.tid; u < (LDS_BYTES - LDSCTL_OFF) / 4; u += NWAVES * 64) ((LAS unsigned*)(F.lds + LDSCTL_OFF))[u] = 0u;
    __syncthreads();
    const XcdBarrier bar = xcd_barrier_post((unsigned*)(args.ws + WS_CTL) + CW_BAR, F.MISC + 8);

    weights_absmax(F);
    phase_sync(F, bar);
    prologue(F);
    phase_sync(F, bar);
    ffn_half<0>(F, bar); mixer<0>(F, bar); ffn_half<1>(F, bar);
    ffn_half<2>(F, bar); mixer<1>(F, bar); ffn_half<3>(F, bar);
    ffn_half<4>(F, bar); mixer<2>(F, bar); ffn_half<5>(F, bar);
    ffn_half<6>(F, bar); mixer<3>(F, bar); ffn_half<7>(F, bar);
}

extern "C" void kernel_launch(void* const* d_in, const int* in_sizes, int n_in, void* d_out, int out_size, void* d_ws, size_t ws_size, hipStream_t stream) {
    static int grid = 0;
    if (grid == 0) {
        if (n_in != 15 || in_sizes[0] != NTOK * D || out_size != NTOK * D || ws_size < WS_END) { fprintf(stderr, "kernel_launch: unexpected shapes (n_in %d, in0 %d, out %d, ws %zu < %zu)\n", n_in, n_in > 0 ? in_sizes[0] : -1, out_size, ws_size, (size_t)WS_END); grid = -1; return; }
        int dev = 0, cus = 0, per_cu = 0;
        if (hipGetDevice(&dev) != hipSuccess || hipDeviceGetAttribute(&cus, hipDeviceAttributeMultiprocessorCount, dev) != hipSuccess) { grid = -1; return; }
        if (hipFuncSetAttribute((const void*)fwd_kernel, hipFuncAttributeMaxDynamicSharedMemorySize, LDS_BYTES) != hipSuccess) { fprintf(stderr, "kernel_launch: hipFuncSetAttribute failed\n"); grid = -1; return; }
        if (hipOccupancyMaxActiveBlocksPerMultiprocessor(&per_cu, (const void*)fwd_kernel, NWAVES * 64, LDS_BYTES) != hipSuccess || per_cu < 1) fprintf(stderr, "kernel_launch: occupancy query reports %d\n", per_cu);
        (void)hipGetLastError();
        grid = cus;
    }
    if (grid < 0) return;
    if (hipMemsetAsync((char*)d_ws + WS_CTL, 0, CTL_ZERO_BYTES, stream) != hipSuccess) return;
    Args a{};
    for (int i = 0; i < 15; ++i) a.in[i] = (const float*)d_in[i];
    a.out = (float*)d_out; a.ws = (unsigned char*)d_ws;
    hipLaunchKernelGGL(fwd_kernel, dim3(grid), dim3(NWAVES * 64), LDS_BYTES, stream, a);
}
```

```cpp
#include <hip/hip_runtime.h>
#include <cstdio>
#include <cstdint>
#define DIFF_FAST 1
#define MOBA_FAST 1
#define NSA_FAST 1
#if DIFF_FAST
#define DIFF_ATTN diff_attn_pipe
#else
#define DIFF_ATTN diff_attn_slow
#endif
#if MOBA_FAST
#define MOBA_ATTN moba_attn_fast2
#else
#define MOBA_ATTN moba_attn_slow
#endif

namespace pg8 {
#define PG8_LAS __attribute__((address_space(3)))
typedef unsigned short bf16_t;
typedef short bf16x8 __attribute__((ext_vector_type(8)));
typedef float f32x4 __attribute__((ext_vector_type(4)));
typedef unsigned u32x4 __attribute__((ext_vector_type(4)));
typedef int i32x4 __attribute__((ext_vector_type(4)));
typedef int i32x8 __attribute__((ext_vector_type(8)));
typedef unsigned u32x2 __attribute__((ext_vector_type(2)));
constexpr int BM = 256, BK = 64, HALF = 128, HTB = HALF * BK * 2  , STAGE_BYTES = 8 * HTB, NXCD = 8, WGM = 8;

__host__ __device__ __forceinline__ int lds_byte(int r, int c) { const int st = (r >> 4) * 2 + (c >> 5), rr = r & 15, cc = c & 31, ob = rr * 64 + cc * 2; return st * 1024 + (ob ^ (((ob >> 9) & 1) << 5)); }
__host__ __device__ __forceinline__ void stage_rc(int b, int& R, int& C) { const int st = b / 1024, sb = b % 1024, swz = sb ^ (((sb >> 9) & 1) << 5); R = (st >> 1) * 16 + swz / 64; C = (st & 1) * 32 + (swz % 64) / 2; }
__host__ __device__ __forceinline__ int perm32(int rho) { const int n = rho >> 4, i = rho & 15; return 8 * (i >> 2) + 4 * n + (i & 3); }

struct Unit { int pm, pn; };
struct Gemm { const bf16_t* A; const bf16_t* Bt; int lda, K; };

struct StaticOrder {
    int nM, nN, nwg, G, c;
    __host__ __device__ void init(int M, int N, int G_, int c_) { nM = M / BM; nN = N / BM; nwg = nM * nN; G = G_; c = c_; }
    __host__ __device__ bool next(int i, Unit& u) const {
        const long L = (long)i * G + c; if (L >= nwg) return false;
        int wgid = (int)L; { const int q = nwg / NXCD, r = nwg % NXCD, xcd = wgid % NXCD, off = wgid / NXCD; wgid = (xcd < r ? xcd * (q + 1) : r * (q + 1) + (xcd - r) * q) + off; }
        const int nig = WGM * nN, gid = wgid / nig, fm = gid * WGM, gsz = (nM - fm) < WGM ? (nM - fm) : WGM;
        u.pm = fm + ((wgid % nig) % gsz); u.pn = (wgid % nig) / gsz; return true;
    }
    __device__ __forceinline__ void a_ready(const Unit&) const {}
    __device__ __forceinline__ void done(const Unit&) const {}
};
struct CmpOrder {
    int G, c;
    __device__ bool next(int i, Unit& u) const { const int L = i * G + c; if (L >= 64) return false; u.pm = L; u.pn = L >> 5; return true; }
    __device__ __forceinline__ void a_ready(const Unit&) const {}
    __device__ __forceinline__ void done(const Unit&) const {}
};

struct TileOrder {
    int G, c, pn;
    __device__ bool next(int i, Unit& u) const { if (c < 0) return false; const int L = i * G + c; if (L >= 128) return false; u.pm = L; u.pn = pn; return true; }
    __device__ __forceinline__ void a_ready(const Unit&) const {}
    __device__ __forceinline__ void done(const Unit&) const {}
};
__device__ __forceinline__ unsigned cvt_pk_bf16(float lo, float hi) { unsigned r; asm volatile("v_cvt_pk_bf16_f32 %0, %1, %2" : "=v"(r) : "v"(lo), "v"(hi)); return r; }
__device__ __forceinline__ u32x4 pack8(const f32x4 v0, const f32x4 v1) { u32x4 w; w.x = cvt_pk_bf16(v0[0], v0[1]); w.y = cvt_pk_bf16(v0[2], v0[3]); w.z = cvt_pk_bf16(v1[0], v1[1]); w.w = cvt_pk_bf16(v1[2], v1[3]); return w; }
__device__ __forceinline__ float sigmoid_f(float x) { return __builtin_amdgcn_rcpf(1.0f + __builtin_amdgcn_exp2f(-1.4426950408889634f * x)); }
__device__ __forceinline__ f32x4 silu4(const f32x4 x) { f32x4 r; r[0] = x[0] * sigmoid_f(x[0]); r[1] = x[1] * sigmoid_f(x[1]); r[2] = x[2] * sigmoid_f(x[2]); r[3] = x[3] * sigmoid_f(x[3]); return r; }

struct EpiPlain {
    static constexpr bool PERM = true, AFTER_DRAIN = false, HAS_PRE = false;
    bf16_t* O; int ldc; const float* oscp;
    __device__ __forceinline__ void operator()(const f32x4 (&acc)[2][2][4][2], const Unit& u, int wr, int wc, int fr, int fq) const {
        const int row0 = u.pm * BM + wr * 64 + fr, col0 = u.pn * BM + wc * 32 + 8 * fq;
        const float osc = oscp ? *oscp : 1.0f;
#pragma unroll
        for (int ai = 0; ai < 2; ++ai)
#pragma unroll
            for (int m = 0; m < 4; ++m) { bf16_t* rowp = O + (size_t)(row0 + ai * HALF + m * 16) * ldc + col0;
#pragma unroll
                for (int bj = 0; bj < 2; ++bj) *(u32x4*)(rowp + bj * HALF) = pack8(acc[ai][bj][m][0] * osc, acc[ai][bj][m][1] * osc); }
    }
};
constexpr float U8_SCALE = 8.0f;
__device__ __forceinline__ unsigned fp8x4(const f32x4 v) {
    const float a = __builtin_amdgcn_fmed3f(v[0] * U8_SCALE, -448.f, 448.f), b = __builtin_amdgcn_fmed3f(v[1] * U8_SCALE, -448.f, 448.f), c = __builtin_amdgcn_fmed3f(v[2] * U8_SCALE, -448.f, 448.f), d = __builtin_amdgcn_fmed3f(v[3] * U8_SCALE, -448.f, 448.f);
    int w = __builtin_amdgcn_cvt_pk_fp8_f32(a, b, 0, false); w = __builtin_amdgcn_cvt_pk_fp8_f32(c, d, w, true); return (unsigned)w;
}
template <bool I8, bool F8OUT> struct EpiSwiGLU {
    static constexpr bool PERM = true, AFTER_DRAIN = false, HAS_PRE = true;
    bf16_t* O; int ldc; const float* rstd; const float* sw; mutable float rsv[8]; mutable f32x4 swv[4];
    __device__ __forceinline__ void pre(const Unit& u, int wr, int wc, int fr, int fq) const {
        const int row0 = u.pm * BM + wr * 64 + fr;
#pragma unroll
        for (int i = 0; i < 8; ++i) rsv[i] = rstd[row0 + (i >> 2) * HALF + (i & 3) * 16];
    }
    __device__ __forceinline__ void operator()(const f32x4 (&acc)[2][2][4][2], const Unit& u, int wr, int wc, int fr, int fq) const {
        const int row0 = u.pm * BM + wr * 64 + fr, col0 = u.pn * HALF + wc * 32 + 8 * fq;
        if constexpr (I8) { const float* p = sw + u.pn * BM + wc * 32 + 8 * fq; swv[0] = *(const f32x4*)p; swv[1] = *(const f32x4*)(p + 4); swv[2] = *(const f32x4*)(p + HALF); swv[3] = *(const f32x4*)(p + HALF + 4); }
#pragma unroll
        for (int ai = 0; ai < 2; ++ai)
#pragma unroll
            for (int m = 0; m < 4; ++m) { bf16_t* rowp = O + (size_t)(row0 + ai * HALF + m * 16) * ldc + col0; const float rs = rsv[ai * 4 + m];
                f32x4 h0, h1;
                if constexpr (I8) { h0 = silu4(acc[ai][0][m][0] * (swv[0] * rs)) * (acc[ai][1][m][0] * (swv[2] * rs)); h1 = silu4(acc[ai][0][m][1] * (swv[1] * rs)) * (acc[ai][1][m][1] * (swv[3] * rs)); }
                else { h0 = silu4(acc[ai][0][m][0] * rs) * (acc[ai][1][m][0] * rs); h1 = silu4(acc[ai][0][m][1] * rs) * (acc[ai][1][m][1] * rs); }
                if constexpr (F8OUT) { u32x2 w8; w8.x = fp8x4(h0); w8.y = fp8x4(h1); *(u32x2*)((unsigned char*)O + (size_t)(row0 + ai * HALF + m * 16) * ldc + col0) = w8; }
                else *(u32x4*)rowp = pack8(h0, h1); }
    }
};
constexpr int SEQ_ = 4096, NTOK_ = 32768;
constexpr float QSCALE = 0.125f * 1.4426950408889634f;
template <int mode, bool I8> struct EpiHeads {
    static constexpr bool PERM = true, AFTER_DRAIN = false, HAS_PRE = false;
    bf16_t* qkv; float* gate; const float* cs; const float* sn; const float* rstd; const float* sw;
    __device__ __forceinline__ void operator()(const f32x4 (&acc)[2][2][4][2], const Unit& u, int wr, int wc, int fr, int fq) const {
        const int pn = u.pn, b = u.pm >> 4, t0 = (u.pm & 15) * BM + wr * 64 + fr;
        f32x4 swv[2][2];
        if constexpr (I8) { const float* sp = sw + pn * BM + wc * 32 + 8 * fq; swv[0][0] = *(const f32x4*)sp; swv[0][1] = *(const f32x4*)(sp + 4); swv[1][0] = *(const f32x4*)(sp + HALF); swv[1][1] = *(const f32x4*)(sp + HALF + 4); }
        if (mode == 2 && pn == 10) {
            const int col = wc * 32 + 8 * fq;
            if (col < 48) {
#pragma unroll
                for (int ai = 0; ai < 2; ++ai)
#pragma unroll
                    for (int m = 0; m < 4; ++m) { float* gp = gate + (size_t)(b * SEQ_ + t0 + ai * HALF + m * 16) * 48 + col; const float rs = rstd[b * SEQ_ + t0 + ai * HALF + m * 16];
                        f32x4 a = acc[ai][0][m][0] * rs, c = acc[ai][0][m][1] * rs;
                        if constexpr (I8) { a = a * swv[0][0]; c = c * swv[0][1]; }
                        *(f32x4*)gp = (f32x4){sigmoid_f(a[0]), sigmoid_f(a[1]), sigmoid_f(a[2]), sigmoid_f(a[3])};
                        *(f32x4*)(gp + 4) = (f32x4){sigmoid_f(c[0]), sigmoid_f(c[1]), sigmoid_f(c[2]), sigmoid_f(c[3])}; }
            }
            return;
        }
        bf16_t* tb; int nh, head0; bool hd128 = false, rope; float sc = 1.0f;
        if (mode == 2) {
            if (pn < 4) { tb = qkv; nh = 16; head0 = pn * 4; rope = true; sc = QSCALE; }
            else { tb = qkv + (size_t)NTOK_ * 1024 + (size_t)(pn - 4) * NTOK_ * 256; nh = 4; head0 = 0; rope = ((pn - 4) & 1) == 0; }
        } else {
            const int tensor = pn >> 2; tb = qkv + (size_t)tensor * NTOK_ * 1024; rope = tensor < 2; if (tensor == 0) sc = QSCALE;
            if (tensor == 2 && mode == 0) { hd128 = true; nh = 8; head0 = (pn & 3) * 2; } else { nh = 16; head0 = (pn & 3) * 4; }
        }
        const bool do_rope = rope && ((wc & 1) == 0);
        const float sgn = fq == 0 ? -1.0f : 1.0f;
#pragma unroll
        for (int ai = 0; ai < 2; ++ai)
#pragma unroll
            for (int m = 0; m < 4; ++m) {
                const int t = t0 + ai * HALF + m * 16; const float rs = rstd[b * SEQ_ + t];
                f32x4 c0 = {1.f, 1.f, 1.f, 1.f}, c1 = c0, s0 = {0.f, 0.f, 0.f, 0.f}, s1 = s0;
                if (do_rope) { c0 = *(const f32x4*)(cs + t * 8); c1 = *(const f32x4*)(cs + t * 8 + 4); s0 = *(const f32x4*)(sn + t * 8); s1 = *(const f32x4*)(sn + t * 8 + 4); }
#pragma unroll
                for (int bj = 0; bj < 2; ++bj) {
                    f32x4 v0 = acc[ai][bj][m][0], v1 = acc[ai][bj][m][1];
                    if constexpr (I8) { v0 = v0 * swv[bj][0]; v1 = v1 * swv[bj][1]; }
                    if (do_rope) {
                        f32x4 o0, o1;
#pragma unroll
                        for (int e = 0; e < 4; ++e) {
                            auto ra = __builtin_amdgcn_permlane16_swap(__float_as_uint(v0[e]), __float_as_uint(v0[e]), false, false);
                            auto rb = __builtin_amdgcn_permlane16_swap(__float_as_uint(v1[e]), __float_as_uint(v1[e]), false, false);
                            o0[e] = __uint_as_float((fq & 1) ? ra[0] : ra[1]); o1[e] = __uint_as_float((fq & 1) ? rb[0] : rb[1]); }
                        if (fq < 2) { v0 = v0 * c0 + (o0 * s0) * sgn; v1 = v1 * c1 + (o1 * s1) * sgn; }
                    }
                    v0 = v0 * (sc * rs); v1 = v1 * (sc * rs);
                    bf16_t* p;
                    if (hd128) p = tb + ((size_t)(b * 8 + head0 + bj) * SEQ_ + t) * 128 + wc * 32 + 8 * fq;
                    else p = tb + ((size_t)(b * nh + head0 + 2 * bj + (wc >> 1)) * SEQ_ + t) * 64 + (wc & 1) * 32 + 8 * fq;
                    *(u32x4*)p = pack8(v0, v1);
                }
            }
    }
};
struct EpiCmp1 {
    static constexpr bool PERM = true, AFTER_DRAIN = false, HAS_PRE = false;
    bf16_t* H; const float* bias;
    __device__ __forceinline__ void operator()(const f32x4 (&acc)[2][2][4][2], const Unit& u, int wr, int wc, int fr, int fq) const {
        const int row0 = u.pm * BM + wr * 64 + fr, col0 = wc * 32 + 8 * fq;
#pragma unroll
        for (int bj = 0; bj < 2; ++bj) { const f32x4 b0 = *(const f32x4*)(bias + u.pn * 256 + col0 + bj * HALF), b1 = *(const f32x4*)(bias + u.pn * 256 + col0 + bj * HALF + 4);
#pragma unroll
            for (int ai = 0; ai < 2; ++ai)
#pragma unroll
                for (int m = 0; m < 4; ++m) *(u32x4*)(H + (size_t)(row0 + ai * HALF + m * 16) * 256 + col0 + bj * HALF) = pack8(silu4(acc[ai][bj][m][0] + b0), silu4(acc[ai][bj][m][1] + b1)); }
    }
};
struct EpiCmp2 {
    static constexpr bool PERM = true, AFTER_DRAIN = false, HAS_PRE = false;
    bf16_t* O;
    __device__ __forceinline__ void operator()(const f32x4 (&acc)[2][2][4][2], const Unit& u, int wr, int wc, int fr, int fq) const {
        if (wc >= 2) return;
        const int row0 = u.pm * BM + wr * 64 + fr, col0 = wc * 32 + 8 * fq;
#pragma unroll
        for (int ai = 0; ai < 2; ++ai)
#pragma unroll
            for (int m = 0; m < 4; ++m) *(u32x4*)(O + (size_t)(row0 + ai * HALF + m * 16) * 64 + col0) = pack8(acc[ai][0][m][0], acc[ai][0][m][1]);
    }
};

template <int QM> struct FragT { typedef bf16x8 type; };
template <> struct FragT<2> { typedef i32x8 type; };
template <class Epi, class Sched, bool ALIGN_EPI = false, bool SP2 = false, int QM = 0>
__device__ __forceinline__ void gemm_phase(PG8_LAS unsigned char* lds, const Gemm g, const Sched& S, const Epi& E, int tid_) {
    asm volatile("" : "+v"(tid_));
    const int tid = tid_, wid = __builtin_amdgcn_readfirstlane(tid >> 6), lane = tid & 63, wr = wid >> 2, wc = wid & 3, fr = lane & 15, fq = lane >> 4;
    const int K = g.K, nt = K / BK;
    unsigned voffA[2], voffB[2];
#pragma unroll
    for (int i = 0; i < 2; ++i) { int R, C; stage_rc(tid * 16 + i * 8192, R, C); const int Rb = Epi::PERM ? ((R & ~31) + perm32(R & 31)) : R;
        voffA[i] = (unsigned)(R * g.lda + C) * 2u; voffB[i] = (unsigned)(Rb * K + C) * 2u; }
    const size_t kstep = (size_t)(BK * 2);
    const size_t hstepB = (size_t)HALF * K * 2, hstepA = (size_t)HALF * g.lda * 2;
    const size_t tstepA = 2 * hstepA, tstepB = 2 * hstepB;
    const unsigned ldsw = (unsigned)wid * 1024u;
    const int aoff = lds_byte(wr * 64 + fr, fq * 8), boff = lds_byte(wc * 32 + fr, fq * 8);
#define PG8_SA(b, h) (((b) * 2 + (h)) * HTB)
#define PG8_SB(b, h) ((4 + (b) * 2 + (h)) * HTB)
#define PG8_STAGE(bufoff, gbase, voff) do { _Pragma("unroll") for (int _i = 0; _i < 2; ++_i) \
        __builtin_amdgcn_global_load_lds((const unsigned*)((const char*)(gbase) + (voff)[_i]), (PG8_LAS unsigned*)(lds + (bufoff) + ldsw + _i * 8192), 16, 0, 0); } while (0)
#define PG8_LD32(p) __builtin_shufflevector(*(const PG8_LAS i32x4*)(p), *(const PG8_LAS i32x4*)((p) + 1024), 0, 1, 2, 3, 4, 5, 6, 7)
#define PG8_LDA(dst, b, h) do { if constexpr (QM == 2) { _Pragma("unroll") for (int m = 0; m < 4; ++m) dst[m][0] = PG8_LD32(lds + PG8_SA(b, h) + aoff + m * 2048); } \
        else { _Pragma("unroll") for (int m = 0; m < 4; ++m) { _Pragma("unroll") for (int k = 0; k < NKF; ++k) dst[m][k] = *(const PG8_LAS frag_t*)(lds + PG8_SA(b, h) + aoff + m * 2048 + k * 1024); } } } while (0)
#define PG8_LDB(dst, b, h) do { if constexpr (QM == 2) { _Pragma("unroll") for (int n = 0; n < 2; ++n) dst[n][0] = PG8_LD32(lds + PG8_SB(b, h) + boff + n * 2048); } \
        else { _Pragma("unroll") for (int n = 0; n < 2; ++n) { _Pragma("unroll") for (int k = 0; k < NKF; ++k) dst[n][k] = *(const PG8_LAS frag_t*)(lds + PG8_SB(b, h) + boff + n * 2048 + k * 1024); } } } while (0)
#define PG8_MMA(ai, bj, At, Bt) do { \
        _Pragma("unroll") for (int m = 0; m < 4; ++m) { _Pragma("unroll") for (int n = 0; n < 2; ++n) { _Pragma("unroll") for (int k = 0; k < NKF; ++k) { \
            if constexpr (QM == 2) asm volatile("v_mfma_f32_16x16x128_f8f6f4 %0, %1, %2, %0" : "+v"(acc[ai][bj][m][n]) : "v"(Bt[n][k]), "v"(At[m][k]));   \
            else if constexpr (QM == 1) acc[ai][bj][m][n] = __builtin_bit_cast(f32x4, __builtin_amdgcn_mfma_i32_16x16x64_i8(__builtin_bit_cast(i32x4, Bt[n][k]), __builtin_bit_cast(i32x4, At[m][k]), __builtin_bit_cast(i32x4, acc[ai][bj][m][n]), 0, 0, 0)); \
            else acc[ai][bj][m][n] = __builtin_amdgcn_mfma_f32_16x16x32_bf16(Bt[n][k], At[m][k], acc[ai][bj][m][n], 0, 0, 0); } } } \
        } while (0)
#define PG8_WAIT_V(n) asm volatile("s_waitcnt vmcnt(" #n ")" ::: "memory")
#define PG8_WAIT_L(n) asm volatile("s_waitcnt lgkmcnt(" #n ")" ::: "memory")
#define PG8_BAR __builtin_amdgcn_s_barrier()
#define PG8_SCHED __builtin_amdgcn_sched_barrier(0)
    Unit cur, nxt; int ui = 0;
    if (!S.next(0, cur)) return;
    f32x4 acc[2][2][4][2];
#pragma unroll
    for (int a = 0; a < 2; ++a)
#pragma unroll
        for (int b = 0; b < 2; ++b)
#pragma unroll
            for (int m = 0; m < 4; ++m)
#pragma unroll
                for (int n = 0; n < 2; ++n) acc[a][b][m][n] = (f32x4){0.f, 0.f, 0.f, 0.f};
    constexpr int NKF = QM == 2 ? 1 : 2;
    typedef typename FragT<QM>::type frag_t;
    frag_t At[4][NKF], B0[2][NKF], B1[2][NKF];
    const char* cA = (const char*)g.A + (size_t)cur.pm * tstepA; const char* cB = (const char*)g.Bt + (size_t)cur.pn * tstepB;
    S.a_ready(cur);
    if constexpr (SP2) {
        PG8_STAGE(PG8_SB(0, 0), cB, voffB); PG8_STAGE(PG8_SB(0, 1), cB + hstepB, voffB); PG8_STAGE(PG8_SA(0, 0), cA, voffA); PG8_STAGE(PG8_SA(0, 1), cA + hstepA, voffA);
        if (wr == 1) PG8_BAR;
        PG8_WAIT_V(2); PG8_BAR;
        PG8_STAGE(PG8_SB(1, 0), cB + kstep, voffB); PG8_STAGE(PG8_SA(1, 0), cA + kstep, voffA); PG8_STAGE(PG8_SB(1, 1), cB + hstepB + kstep, voffB);
        PG8_WAIT_V(6); PG8_BAR;
    } else {
        PG8_STAGE(PG8_SB(0, 0), cB, voffB); PG8_STAGE(PG8_SA(0, 0), cA, voffA); PG8_STAGE(PG8_SB(0, 1), cB + hstepB, voffB); PG8_STAGE(PG8_SA(0, 1), cA + hstepA, voffA);
        if (wr == 1) PG8_BAR;
        PG8_WAIT_V(4); PG8_BAR;
        PG8_STAGE(PG8_SB(1, 0), cB + kstep, voffB); PG8_STAGE(PG8_SA(1, 0), cA + kstep, voffA); PG8_STAGE(PG8_SB(1, 1), cB + hstepB + kstep, voffB);
        PG8_WAIT_V(6); PG8_BAR;
    }
    for (;;) {
        if constexpr (Epi::HAS_PRE) E.pre(cur, wr, wc, fr, fq);
        const bool has_next = S.next(ui + 1, nxt);
        const char* nA = has_next ? (const char*)g.A + (size_t)nxt.pm * tstepA : cA; const char* nB = has_next ? (const char*)g.Bt + (size_t)nxt.pn * tstepB : cB;
        for (int t = 0; t < nt; t += 2) {
            const bool last = (t == nt - 2);
            const char* a1 = cA + (size_t)(t + 1) * kstep;
            const char* a2 = last ? nA : cA + (size_t)(t + 2) * kstep; const char* b2 = last ? nB : cB + (size_t)(t + 2) * kstep;
            const char* a3 = a2 + kstep; const char* b3 = b2 + kstep;
            if (last && has_next) S.a_ready(nxt);
            if constexpr (SP2) {
            PG8_LDB(B0, 0, 0); PG8_LDB(B1, 0, 1); PG8_SCHED; PG8_LDA(At, 0, 0); PG8_STAGE(PG8_SA(1, 1), a1 + hstepA, voffA);
            PG8_WAIT_V(8); PG8_WAIT_L(0); __builtin_amdgcn_s_setprio(1); PG8_BAR; PG8_MMA(0, 0, At, B0); PG8_MMA(0, 1, At, B1); __builtin_amdgcn_s_setprio(0); PG8_BAR; PG8_SCHED;
            PG8_LDA(At, 0, 1); PG8_STAGE(PG8_SB(0, 0), b2, voffB); PG8_STAGE(PG8_SB(0, 1), b2 + hstepB, voffB); PG8_STAGE(PG8_SA(0, 0), a2, voffA);
            PG8_WAIT_V(8); PG8_WAIT_L(0); __builtin_amdgcn_s_setprio(1); PG8_BAR; PG8_MMA(1, 0, At, B0); PG8_MMA(1, 1, At, B1); __builtin_amdgcn_s_setprio(0); PG8_BAR; PG8_SCHED;
            PG8_LDB(B0, 1, 0); PG8_LDB(B1, 1, 1); PG8_SCHED; PG8_LDA(At, 1, 0); PG8_STAGE(PG8_SA(0, 1), a2 + hstepA, voffA);
            PG8_WAIT_V(8); PG8_WAIT_L(0); __builtin_amdgcn_s_setprio(1); PG8_BAR; PG8_MMA(0, 0, At, B0); PG8_MMA(0, 1, At, B1); __builtin_amdgcn_s_setprio(0); PG8_BAR; PG8_SCHED;
            PG8_LDA(At, 1, 1); PG8_STAGE(PG8_SB(1, 0), b3, voffB); PG8_STAGE(PG8_SB(1, 1), b3 + hstepB, voffB); PG8_STAGE(PG8_SA(1, 0), a3, voffA);
            PG8_WAIT_V(8); PG8_WAIT_L(0); __builtin_amdgcn_s_setprio(1); PG8_BAR; PG8_MMA(1, 0, At, B0); PG8_MMA(1, 1, At, B1); __builtin_amdgcn_s_setprio(0); PG8_BAR; PG8_SCHED;
            } else {
            PG8_LDB(B0, 0, 0); PG8_SCHED; PG8_LDA(At, 0, 0); PG8_STAGE(PG8_SA(1, 1), a1 + hstepA, voffA);
            PG8_WAIT_L(8); PG8_BAR; PG8_WAIT_L(0); PG8_MMA(0, 0, At, B0); PG8_BAR; PG8_SCHED;
            PG8_LDB(B1, 0, 1); PG8_STAGE(PG8_SB(0, 0), b2, voffB);
            PG8_BAR; PG8_WAIT_L(0); PG8_MMA(0, 1, At, B1); PG8_BAR;
            PG8_LDA(At, 0, 1); PG8_STAGE(PG8_SA(0, 0), a2, voffA);
            PG8_BAR; PG8_WAIT_L(0); PG8_MMA(1, 0, At, B0); PG8_BAR; PG8_SCHED;
            PG8_STAGE(PG8_SB(0, 1), b2 + hstepB, voffB);
            PG8_WAIT_V(6); PG8_BAR; PG8_MMA(1, 1, At, B1); PG8_BAR;
            PG8_LDB(B0, 1, 0); PG8_SCHED; PG8_LDA(At, 1, 0); PG8_STAGE(PG8_SA(0, 1), a2 + hstepA, voffA);
            PG8_WAIT_L(8); PG8_BAR; PG8_WAIT_L(0); PG8_MMA(0, 0, At, B0); PG8_BAR; PG8_SCHED;
            PG8_LDB(B1, 1, 1); PG8_STAGE(PG8_SB(1, 0), b3, voffB);
            PG8_BAR; PG8_WAIT_L(0); PG8_MMA(0, 1, At, B1); PG8_BAR;
            PG8_LDA(At, 1, 1); PG8_STAGE(PG8_SA(1, 0), a3, voffA);
            PG8_BAR; PG8_WAIT_L(0); PG8_MMA(1, 0, At, B0); PG8_BAR; PG8_SCHED;
            PG8_STAGE(PG8_SB(1, 1), b3 + hstepB, voffB);
            PG8_WAIT_V(6); PG8_BAR; PG8_MMA(1, 1, At, B1); PG8_BAR;
            }
        }
        if constexpr (ALIGN_EPI) { if (wr == 0) PG8_BAR; }
        if constexpr (QM == 2) asm volatile("s_nop 15\n\ts_nop 15\n\ts_nop 15" ::: "memory");
        if constexpr (QM == 1) {
#pragma unroll
            for (int a = 0; a < 2; ++a)
#pragma unroll
                for (int b = 0; b < 2; ++b)
#pragma unroll
                    for (int m = 0; m < 4; ++m)
#pragma unroll
                        for (int n = 0; n < 2; ++n) acc[a][b][m][n] = __builtin_convertvector(__builtin_bit_cast(i32x4, acc[a][b][m][n]), f32x4);
        }
        if constexpr (!Epi::AFTER_DRAIN) { E(acc, cur, wr, wc, fr, fq); S.done(cur); }
        if (!has_next) break;
#pragma unroll
        for (int a = 0; a < 2; ++a)
#pragma unroll
            for (int b = 0; b < 2; ++b)
#pragma unroll
                for (int m = 0; m < 4; ++m)
#pragma unroll
                    for (int n = 0; n < 2; ++n) acc[a][b][m][n] = (f32x4){0.f, 0.f, 0.f, 0.f};
        cur = nxt; cA = nA; cB = nB; ++ui;
        if constexpr (ALIGN_EPI) { if (wr == 1) PG8_BAR; }
    }
    PG8_WAIT_V(0);
    if constexpr (!ALIGN_EPI) { if (wr == 0) PG8_BAR; }
    PG8_BAR;
    if constexpr (Epi::AFTER_DRAIN) { E.fused(acc, cur, wr, wc, fr, fq, lds, wid, lane); S.done(cur); }
#undef PG8_SA
#undef PG8_SB
#undef PG8_STAGE
#undef PG8_LDA
#undef PG8_LD32
#undef PG8_LDB
#undef PG8_MMA
#undef PG8_WAIT_V
#undef PG8_WAIT_L
#undef PG8_BAR
#undef PG8_SCHED
}
}

constexpr int NWAVES = 8;
constexpr int BATCH = 8, SEQ = 4096, D = 1024, NTOK = BATCH * SEQ, DFF = 2816, DEPTH = 4;
constexpr float NORM_EPS = 1e-6f;
constexpr int NSA_IN = 2608, NSA_IN_PAD = 2816;

constexpr size_t MiB = 1u << 20;
constexpr size_t WS_CTL = 0, CTL_ZERO_BYTES = 32768;
constexpr size_t WS_TAB = 1 * MiB;
constexpr size_t TAB_COS = WS_TAB, TAB_SIN = WS_TAB + 128 * 1024, TAB_CBIAS = WS_TAB + 256 * 1024, TAB_LAM = WS_TAB + 260 * 1024, TAB_KMEAN = WS_TAB + 512 * 1024, TAB_RSTD = WS_TAB + 1024 * 1024, TAB_CBP = WS_TAB + 1152 * 1024, TAB_RS8 = WS_TAB + 1280 * 1024, TAB_SW = WS_TAB + 1408 * 1024, TAB_SWI = WS_TAB + 1600 * 1024, TAB_SW2 = WS_TAB + 1792 * 1024, TAB_SWI2 = WS_TAB + 1856 * 1024;
constexpr size_t WS_SEL = 3 * MiB;
constexpr size_t WS_GATE = 4 * MiB;
constexpr size_t WS_KVC = 10 * MiB;
constexpr size_t WS_CH = 12 * MiB;
constexpr size_t WS_W = 20 * MiB;
constexpr size_t W_FFN_IN = WS_W, FFN_IN_BYTES = (size_t)2 * DFF * D * 2;
constexpr size_t W_FFN_OUT = W_FFN_IN + 8 * FFN_IN_BYTES, FFN_OUT_BYTES = (size_t)D * DFF * 2;
constexpr size_t W_DIFF_IN = W_FFN_OUT + 8 * FFN_OUT_BYTES;
constexpr size_t W_DIFF_OUT = W_DIFF_IN + 2 * 6 * MiB;
constexpr size_t W_MOBA_IN = W_DIFF_OUT + 2 * 2 * MiB;
constexpr size_t W_MOBA_OUT = W_MOBA_IN + 6 * MiB;
constexpr size_t W_NSA_IN = W_MOBA_OUT + 2 * MiB;
constexpr size_t W_NSA_OUT = W_NSA_IN + (size_t)NSA_IN_PAD * D * 2;
constexpr size_t W_CMP1 = W_NSA_OUT + 2 * MiB;
constexpr size_t W_CMP2 = W_CMP1 + 2 * MiB;
constexpr size_t W_END = W_CMP2 + 256 * 1024;
constexpr size_t WS_XN = 188 * MiB;
constexpr size_t WS_Y = WS_XN + 64 * MiB;
constexpr size_t WS_ATT = WS_Y + 64 * MiB;
constexpr size_t WS_U = WS_ATT + 64 * MiB;
constexpr size_t WS_H8 = WS_U + 192 * MiB + 1 * MiB;
constexpr size_t WS_END = WS_H8 + 32 * MiB;
static_assert(W_END <= WS_XN, "weights overflow");

constexpr int CW_BAR = 4096;
constexpr int CW_WOMAX = 64;
constexpr float W8_TOP = 224.0f;

constexpr int LDS_BYTES = 147456;
constexpr int LDSCTL_OFF = LDS_BYTES - 512;

#define GAS __attribute__((address_space(1)))
#define LAS __attribute__((address_space(3)))
typedef unsigned short bf16;
typedef unsigned v4u __attribute__((ext_vector_type(4)));
typedef float f32x4 __attribute__((ext_vector_type(4)));
#define LDS_WAIT() asm volatile("s_waitcnt lgkmcnt(0)" ::: "memory")
__device__ __forceinline__ unsigned f2bf(float f) { unsigned u = __builtin_bit_cast(unsigned, f); return (u + 0x7fffu + ((u >> 16) & 1u)) >> 16; }
__device__ __forceinline__ unsigned pk2(float lo, float hi) { return f2bf(lo) | (f2bf(hi) << 16); }
__device__ __forceinline__ float bflo(unsigned u) { return __uint_as_float(u << 16); }
__device__ __forceinline__ float bfhi(unsigned u) { return __uint_as_float(u & 0xffff0000u); }
__device__ __forceinline__ float ex2(float x) { return __builtin_amdgcn_exp2f(x); }

#define XB_TMO      128
#define XB_XCNT(j)  (256  + 64 * (j))
#define XB_XSUB(j)  (1280 + 64 * (j))
#define XB_XGEN(j)  (2304 + 64 * (j))
#define XB_TOP      3328
#define XB_TOPGEN   3392
#define XCD_BAR_WORDS 3456
#define XB_SPIN_CAP (1u << 18)

__device__ __forceinline__ unsigned xb_ld(unsigned* p)              { return __hip_atomic_load(p, __ATOMIC_RELAXED, __HIP_MEMORY_SCOPE_AGENT); }
__device__ __forceinline__ unsigned xb_add(unsigned* p, unsigned v) { return __hip_atomic_fetch_add(p, v, __ATOMIC_RELAXED, __HIP_MEMORY_SCOPE_AGENT); }
__device__ __forceinline__ unsigned xb_xcc_id() { return (unsigned)__builtin_amdgcn_s_getreg((3 << 11) | 20) & 0xFu; }
#define XB_SPIN(cond, bar) do { unsigned _sp = 0; while (cond) { __builtin_amdgcn_s_sleep(1); \
    if ((++_sp & 255u) == 0u) { if (xb_ld(&(bar)[XB_TMO])) break; if (_sp > XB_SPIN_CAP) { atomicAdd(&(bar)[XB_TMO], 1u); break; } } } } while (0)

struct XcdBarrier {
    unsigned* bar; unsigned x;
    volatile LAS unsigned* st;
};

__device__ __forceinline__ XcdBarrier xcd_barrier_post(unsigned* bar, volatile LAS unsigned* st) {
    XcdBarrier b; b.bar = bar; b.x = xb_xcc_id(); b.st = st;
    if (threadIdx.x == 0) (void)xb_add(&bar[XB_XCNT(b.x)], 1u);
    return b;
}
__device__ __forceinline__ void xcd_barrier_complete(unsigned* bar, unsigned x, unsigned& nloc, unsigned& nx) {
    const unsigned G = gridDim.x * gridDim.y * gridDim.z;
    unsigned sum, cnt, mine, sp = 0u;
    for (;;) {
        sum = 0u; cnt = 0u; mine = 0u;
#pragma unroll
        for (unsigned j = 0; j < 16; ++j) { const unsigned c = xb_ld(&bar[XB_XCNT(j)]); sum += c; cnt += (c > 0u) ? 1u : 0u; mine = (j == x) ? c : mine; }
        if (sum == G) break;
        __builtin_amdgcn_s_sleep(1);
        if ((++sp & 255u) == 0u) { if (xb_ld(&bar[XB_TMO])) break; if (sp > XB_SPIN_CAP) { atomicAdd(&bar[XB_TMO], 1u); break; } }
    }
    nloc = mine > 0u ? mine : 1u; nx = cnt > 0u ? cnt : 1u;
}

__device__ __forceinline__ void xcd_barrier(const XcdBarrier& b, bool t0) {
    asm volatile("s_waitcnt vmcnt(0)" ::: "memory");
    __syncthreads();
    if (t0) {
        unsigned* bar = b.bar;
        __builtin_amdgcn_s_waitcnt(0);
        unsigned nloc = b.st[0], nx = b.st[1];
        if (nloc == 0u) { xcd_barrier_complete(bar, b.x, nloc, nx); b.st[0] = nloc; b.st[1] = nx; }
        const unsigned old = xb_add(&bar[XB_XSUB(b.x)], 1u);
        const unsigned gen = old / nloc;
        if (old + 1u == (gen + 1u) * nloc) {
            __builtin_amdgcn_fence(__ATOMIC_RELEASE, "agent");
            asm volatile("s_waitcnt vmcnt(0)" ::: "memory");
            const unsigned og = xb_add(&bar[XB_TOP], 1u);
            const unsigned tg = og / nx;
            if (og + 1u == (tg + 1u) * nx) xb_add(&bar[XB_TOPGEN], 1u);
            else XB_SPIN(xb_ld(&bar[XB_TOPGEN]) == tg, bar);
            __builtin_amdgcn_fence(__ATOMIC_ACQUIRE, "agent");
            xb_add(&bar[XB_XGEN(b.x)], 1u);
            asm volatile("s_waitcnt vmcnt(0)" ::: "memory");
        } else {
            XB_SPIN(xb_ld(&bar[XB_XGEN(b.x)]) == gen, bar);
            __builtin_amdgcn_fence(__ATOMIC_ACQUIRE, "agent");
            asm volatile("s_waitcnt vmcnt(0)" ::: "memory");
        }
    }
    __syncthreads();
}

struct Args { const float* in[15]; float* out; unsigned char* ws; };
struct InPtrs { const Args* a; __device__ __forceinline__ const float* operator[](int i) const { return a->in[i]; } };
struct Frame {
    LAS unsigned char* lds;
    volatile LAS unsigned* MISC;
    int tid, lane, wave, G, vcu;
    InPtrs in; float* out; unsigned char* ws;
};
template <int CTRL> __device__ __forceinline__ float dpp_mov(float v) { return __builtin_bit_cast(float, __builtin_amdgcn_update_dpp(0, __builtin_bit_cast(int, v), CTRL, 0xF, 0xF, true)); }
__device__ __forceinline__ float wave_sum(float v) {
    v += dpp_mov<0xB1>(v); v += dpp_mov<0x4E>(v); v += dpp_mov<0x141>(v); v += dpp_mov<0x140>(v);
    { auto r = __builtin_amdgcn_permlane16_swap(__float_as_uint(v), __float_as_uint(v), false, false); v = __uint_as_float(r[0]) + __uint_as_float(r[1]); }
    { auto r = __builtin_amdgcn_permlane32_swap(__float_as_uint(v), __float_as_uint(v), false, false); v = __uint_as_float(r[0]) + __uint_as_float(r[1]); }
    return v;
}
__device__ __forceinline__ float wave_max(float v) {
    v = fmaxf(v, dpp_mov<0xB1>(v)); v = fmaxf(v, dpp_mov<0x4E>(v)); v = fmaxf(v, dpp_mov<0x141>(v)); v = fmaxf(v, dpp_mov<0x140>(v));
    { auto r = __builtin_amdgcn_permlane16_swap(__float_as_uint(v), __float_as_uint(v), false, false); v = fmaxf(__uint_as_float(r[0]), __uint_as_float(r[1])); }
    { auto r = __builtin_amdgcn_permlane32_swap(__float_as_uint(v), __float_as_uint(v), false, false); v = fmaxf(__uint_as_float(r[0]), __uint_as_float(r[1])); }
    return v;
}
__device__ __forceinline__ unsigned q8x4(float a, float b, float c, float d) {
    const int ia = (int)__builtin_rintf(a), ib = (int)__builtin_rintf(b), ic = (int)__builtin_rintf(c), id = (int)__builtin_rintf(d);
    return ((unsigned)ia & 255u) | (((unsigned)ib & 255u) << 8) | (((unsigned)ic & 255u) << 16) | ((unsigned)id << 24);
}

__device__ __forceinline__ void phase_sync(Frame& F, const XcdBarrier& bar) {
    xcd_barrier(bar, F.tid == 0);
    int l; asm volatile("v_mbcnt_lo_u32_b32 %0, -1, 0\n\tv_mbcnt_hi_u32_b32 %0, -1, %0" : "=v"(l));
    F.lane = l; F.tid = F.wave * 64 + l;
}
__device__ __forceinline__ void conv_load(const float* W, int N, int item, int nblk, int lane, float (&v)[32]) {
    const int kb = item / nblk, nb = item % nblk, k0 = 64 * kb, n0 = 32 * nb;
    const int col = n0 + (lane & 31); const bool ok = col < N;
    const float* p = W + (size_t)(k0 + (lane >> 5)) * N + col;
#pragma unroll
    for (int i = 0; i < 32; ++i) v[i] = ok ? p[(size_t)(2 * i) * N] : 0.f;
}
__device__ __forceinline__ void conv_store(const float (&v)[32], int K, bf16* WT, int mode, LAS float* scr, int item, int nblk, int lane, const float* gk, const float* swi, const float* womax) {
    const int kb = item / nblk, nb = item % nblk, k0 = 64 * kb, n0 = 32 * nb;
#pragma unroll
    for (int i = 0; i < 32; ++i) scr[(2 * i + (lane >> 5)) * 33 + (lane & 31)] = v[i];
    LDS_WAIT(); asm volatile("" ::: "memory");
    int r0 = n0;
    if (mode == 1) { const int up = n0 >= DFF ? 1 : 0, j = n0 - up * DFF; r0 = 256 * (j >> 7) + 128 * up + (j & 127); }
    const int c = lane & 7;
    f32x4 g0 = {1.f, 1.f, 1.f, 1.f}, g1 = g0;
    if (gk) { g0 = *(const f32x4*)(gk + k0 + 8 * c); g1 = *(const f32x4*)(gk + k0 + 8 * c + 4); }
#pragma unroll
    for (int j = 0; j < 4; ++j) { const int n = (lane >> 3) + 8 * j; const LAS float* s = scr + (8 * c) * 33 + n;
        v4u o; o.x = pk2(s[0 * 33] * g0[0], s[1 * 33] * g0[1]); o.y = pk2(s[2 * 33] * g0[2], s[3 * 33] * g0[3]); o.z = pk2(s[4 * 33] * g1[0], s[5 * 33] * g1[1]); o.w = pk2(s[6 * 33] * g1[2], s[7 * 33] * g1[3]);
        if (womax) { const float am = *womax, qf = am > 0.f ? W8_TOP / am : 0.f; typedef unsigned u2 __attribute__((ext_vector_type(2)));
            int w0 = __builtin_amdgcn_cvt_pk_fp8_f32(s[0 * 33] * qf, s[1 * 33] * qf, 0, false); w0 = __builtin_amdgcn_cvt_pk_fp8_f32(s[2 * 33] * qf, s[3 * 33] * qf, w0, true);
            int w1 = __builtin_amdgcn_cvt_pk_fp8_f32(s[4 * 33] * qf, s[5 * 33] * qf, 0, false); w1 = __builtin_amdgcn_cvt_pk_fp8_f32(s[6 * 33] * qf, s[7 * 33] * qf, w1, true);
            u2 o8; o8.x = (unsigned)w0; o8.y = (unsigned)w1; *(GAS u2*)((unsigned char*)WT + (size_t)(r0 + n) * K + k0 + 8 * c) = o8; continue; }
        if (swi) { const float qi = swi[r0 + n]; typedef unsigned u2 __attribute__((ext_vector_type(2)));
            u2 o8; o8.x = q8x4(s[0 * 33] * g0[0] * qi, s[1 * 33] * g0[1] * qi, s[2 * 33] * g0[2] * qi, s[3 * 33] * g0[3] * qi); o8.y = q8x4(s[4 * 33] * g1[0] * qi, s[5 * 33] * g1[1] * qi, s[6 * 33] * g1[2] * qi, s[7 * 33] * g1[3] * qi);
            *(GAS u2*)((unsigned char*)WT + (size_t)(r0 + n) * K + k0 + 8 * c) = o8; continue; }
        *(GAS v4u*)(WT + (size_t)(r0 + n) * K + k0 + 8 * c) = o; }
    LDS_WAIT(); asm volatile("" ::: "memory");
}
__device__ __forceinline__ void conv_matrix(Frame& F, int& base, const float* W, int K, int N, int Npad, bf16* WT, int mode, const float* gk = nullptr, const float* swi = nullptr, const float* womax = nullptr) {
    LAS float* scr = (LAS float*)(F.lds + F.wave * 16384);
    const int gw = blockIdx.x * NWAVES + F.wave, NGW = F.G * NWAVES;
    const int nblk = Npad / 32, items = (K / 64) * nblk;
    int it = (gw + NGW - base % NGW) % NGW;
    base += items;
    float v[32];
    if (it < items) conv_load(W, N, it, nblk, F.lane, v);
    while (it < items) {
        const int nx = it + NGW; float v2[32];
        if (nx < items) conv_load(W, N, nx, nblk, F.lane, v2);
        conv_store(v, K, WT, mode, scr, it, nblk, F.lane, gk, swi, womax);
#pragma unroll
        for (int i = 0; i < 32; ++i) v[i] = v2[i];
        it = nx;
    }
}

constexpr int RPT = 4;
__device__ __forceinline__ void rows_phase(Frame& F, const float* x, const bf16* y, float coef, const float* gpost, bf16* H, float* RS, float* fout) {
    unsigned char* H8 = F.ws + WS_H8; float* RS8 = (float*)(F.ws + TAB_RS8);
    const int gw = blockIdx.x * NWAVES + F.wave, NGW = F.G * NWAVES;
    int lane_ = F.lane; asm volatile("" : "+v"(lane_));
    const int c0 = 8 * lane_;
    float gp[16];
#pragma unroll
    for (int k = 0; k < 16; ++k) gp[k] = y ? gpost[c0 + (k >> 3) * 512 + (k & 7)] : 0.f;
    for (int row0 = gw; row0 < NTOK; row0 += RPT * NGW) {
        float hv[RPT][16], yv[RPT][16];
#pragma unroll
        for (int u = 0; u < RPT; ++u) {
            const int row = row0 + u * NGW; if (row >= NTOK) break;
            if (y) {
                const bf16* hr = H + (size_t)row * D + c0; const bf16* yr = y + (size_t)row * D + c0;
#pragma unroll
                for (int j = 0; j < 2; ++j) { const v4u w = *(const v4u*)(hr + j * 512), q = *(const v4u*)(yr + j * 512);
                    hv[u][8 * j + 0] = bflo(w.x); hv[u][8 * j + 1] = bfhi(w.x); hv[u][8 * j + 2] = bflo(w.y); hv[u][8 * j + 3] = bfhi(w.y); hv[u][8 * j + 4] = bflo(w.z); hv[u][8 * j + 5] = bfhi(w.z); hv[u][8 * j + 6] = bflo(w.w); hv[u][8 * j + 7] = bfhi(w.w);
                    yv[u][8 * j + 0] = bflo(q.x); yv[u][8 * j + 1] = bfhi(q.x); yv[u][8 * j + 2] = bflo(q.y); yv[u][8 * j + 3] = bfhi(q.y); yv[u][8 * j + 4] = bflo(q.z); yv[u][8 * j + 5] = bfhi(q.z); yv[u][8 * j + 6] = bflo(q.w); yv[u][8 * j + 7] = bfhi(q.w); }
            } else {
                const float* xr = x + (size_t)row * D + c0;
#pragma unroll
                for (int j = 0; j < 2; ++j) { const f32x4 a = *(const f32x4*)(xr + j * 512), b = *(const f32x4*)(xr + j * 512 + 4);
                    hv[u][8 * j + 0] = a[0]; hv[u][8 * j + 1] = a[1]; hv[u][8 * j + 2] = a[2]; hv[u][8 * j + 3] = a[3]; hv[u][8 * j + 4] = b[0]; hv[u][8 * j + 5] = b[1]; hv[u][8 * j + 6] = b[2]; hv[u][8 * j + 7] = b[3]; }
            }
        }
#pragma unroll
        for (int u = 0; u < RPT; ++u) {
            const int row = row0 + u * NGW; if (row >= NTOK) break;
            if (y) {
                float ss = 0.f;
#pragma unroll
                for (int k = 0; k < 16; ++k) ss += yv[u][k] * yv[u][k];
                ss = wave_sum(ss);
                const float r = coef * __builtin_amdgcn_rsqf(ss * (1.0f / D) + NORM_EPS);
#pragma unroll
                for (int k = 0; k < 16; ++k) hv[u][k] += yv[u][k] * r * gp[k];
            }
            if (fout) {
                float* ho = fout + (size_t)row * D + c0;
#pragma unroll
                for (int j = 0; j < 2; ++j) { *(f32x4*)(ho + j * 512) = (f32x4){hv[u][8 * j], hv[u][8 * j + 1], hv[u][8 * j + 2], hv[u][8 * j + 3]}; *(f32x4*)(ho + j * 512 + 4) = (f32x4){hv[u][8 * j + 4], hv[u][8 * j + 5], hv[u][8 * j + 6], hv[u][8 * j + 7]}; }
            } else {
                float ss = 0.f;
#pragma unroll
                for (int k = 0; k < 16; ++k) ss += hv[u][k] * hv[u][k];
                ss = wave_sum(ss);
                const float rstd = __builtin_amdgcn_rsqf(ss * (1.0f / D) + NORM_EPS);
                float am = 0.f;
#pragma unroll
                for (int k = 0; k < 16; ++k) am = fmaxf(am, fabsf(hv[u][k]));
                am = wave_max(am);
                const float qs = am > 0.f ? 127.0f / am : 0.f;
                if (lane_ == 0) { RS[row] = rstd; RS8[row] = rstd * am * (1.0f / 127.0f); }
                typedef unsigned u2 __attribute__((ext_vector_type(2)));
#pragma unroll
                for (int j = 0; j < 2; ++j) { u2 w8; w8.x = q8x4(hv[u][8 * j] * qs, hv[u][8 * j + 1] * qs, hv[u][8 * j + 2] * qs, hv[u][8 * j + 3] * qs); w8.y = q8x4(hv[u][8 * j + 4] * qs, hv[u][8 * j + 5] * qs, hv[u][8 * j + 6] * qs, hv[u][8 * j + 7] * qs);
                    *(u2*)(H8 + (size_t)row * D + c0 + j * 512) = w8; }
                bf16* hw = H + (size_t)row * D + c0;
#pragma unroll
                for (int j = 0; j < 2; ++j) { v4u w; w.x = pk2(hv[u][8 * j], hv[u][8 * j + 1]); w.y = pk2(hv[u][8 * j + 2], hv[u][8 * j + 3]); w.z = pk2(hv[u][8 * j + 4], hv[u][8 * j + 5]); w.w = pk2(hv[u][8 * j + 6], hv[u][8 * j + 7]);
                    *(v4u*)(hw + j * 512) = w; }
            }
        }
    }
}

__device__ __forceinline__ void load_row64(const bf16* p, float (&q)[64]) {
#pragma unroll
    for (int i = 0; i < 8; ++i) { const v4u w = ((const v4u*)p)[i];
        q[8 * i + 0] = bflo(w.x); q[8 * i + 1] = bfhi(w.x); q[8 * i + 2] = bflo(w.y); q[8 * i + 3] = bfhi(w.y); q[8 * i + 4] = bflo(w.z); q[8 * i + 5] = bfhi(w.z); q[8 * i + 6] = bflo(w.w); q[8 * i + 7] = bfhi(w.w); }
}
__device__ __forceinline__ float dot64_bf(const float (&q)[64], const bf16* kp) {
    float s0 = 0.f, s1 = 0.f, s2 = 0.f, s3 = 0.f;
#pragma unroll
    for (int i = 0; i < 8; ++i) { const v4u w = ((const v4u*)kp)[i];
        s0 += q[8 * i + 0] * bflo(w.x); s1 += q[8 * i + 1] * bfhi(w.x); s2 += q[8 * i + 2] * bflo(w.y); s3 += q[8 * i + 3] * bfhi(w.y);
        s0 += q[8 * i + 4] * bflo(w.z); s1 += q[8 * i + 5] * bfhi(w.z); s2 += q[8 * i + 6] * bflo(w.w); s3 += q[8 * i + 7] * bfhi(w.w); }
    return (s0 + s1) + (s2 + s3);
}
template <int DV>
__device__ __forceinline__ void attend_key(const float (&q)[64], const bf16* kp, const bf16* vp, bool valid, float& m, float& l, float (&o)[DV]) {
    const float s = dot64_bf(q, kp);
    if (valid) {
        const float mn = fmaxf(m, s), a = ex2(m - mn), p = ex2(s - mn); l = l * a + p; m = mn;
#pragma unroll
        for (int i = 0; i < DV / 8; ++i) { const v4u w = ((const v4u*)vp)[i];
            o[8 * i + 0] = o[8 * i + 0] * a + p * bflo(w.x); o[8 * i + 1] = o[8 * i + 1] * a + p * bfhi(w.x); o[8 * i + 2] = o[8 * i + 2] * a + p * bflo(w.y); o[8 * i + 3] = o[8 * i + 3] * a + p * bfhi(w.y);
            o[8 * i + 4] = o[8 * i + 4] * a + p * bflo(w.z); o[8 * i + 5] = o[8 * i + 5] * a + p * bfhi(w.z); o[8 * i + 6] = o[8 * i + 6] * a + p * bflo(w.w); o[8 * i + 7] = o[8 * i + 7] * a + p * bfhi(w.w); }
    }
}
__device__ __forceinline__ int qperm(int slot) { const int g = slot >> 2, j = slot & 3; return j == 0 ? g : (j == 1 ? 15 - g : (j == 2 ? 7 - g : 8 + g)); }
template <int DV>
__device__ __forceinline__ void store_row_bf16(bf16* op, const float (&o)[DV], float sc) {
#pragma unroll
    for (int i = 0; i < DV / 8; ++i) { v4u w; w.x = pk2(o[8 * i] * sc, o[8 * i + 1] * sc); w.y = pk2(o[8 * i + 2] * sc, o[8 * i + 3] * sc); w.z = pk2(o[8 * i + 4] * sc, o[8 * i + 5] * sc); w.w = pk2(o[8 * i + 6] * sc, o[8 * i + 7] * sc);
        ((v4u*)op)[i] = w; }
}

__device__ __forceinline__ void diff_attn_slow(Frame& F, const bf16* Q, const bf16* K, const bf16* V, bf16* ATT, float lam, float lambda_init, const float* subln) {
    LAS float* X = (LAS float*)F.lds;
    for (int wslot = blockIdx.x; wslot < 256; wslot += F.G)
        for (int i = 0; i < 4; ++i) {
            const int id = wslot * 4 + i, bh = id >> 4, qb = qperm(id & 15), b = bh >> 3, h = bh & 7;
            const int c = F.wave >> 2, row = F.tid & 255, t = qb * 256 + row, sub = h * 2 + c;
            float q[64]; load_row64(Q + ((size_t)(b * 16 + sub) * SEQ + t) * 64, q);
            const bf16* Kb = K + (size_t)(b * 16 + sub) * SEQ * 64; const bf16* Vb = V + (size_t)(b * 8 + h) * SEQ * 128;
            const int tmax = __builtin_amdgcn_readfirstlane(qb * 256 + (row | 63));
            float ss = 0.f;
            for (int dh = 0; dh < 2; ++dh) {
                float m = -INFINITY, l = 0.f; float o[64];
#pragma unroll
                for (int d = 0; d < 64; ++d) o[d] = 0.f;
                for (int key = 0; key <= tmax; ++key) attend_key<64>(q, Kb + (size_t)key * 64, Vb + (size_t)key * 128 + dh * 64, key <= t, m, l, o);
                const float il = 1.0f / l;
                if (c == 1) {
#pragma unroll
                    for (int d = 0; d < 64; ++d) X[row * 129 + dh * 64 + d] = o[d] * il * lam;
                }
                __syncthreads();
                if (c == 0) {
#pragma unroll
                    for (int d = 0; d < 64; ++d) { const float a = o[d] * il - X[row * 129 + dh * 64 + d]; ss += a * a; X[row * 129 + dh * 64 + d] = a * subln[dh * 64 + d]; }
                }
            }
            if (c == 0) {
                const float r = __builtin_amdgcn_rsqf(ss * (1.0f / 128.0f) + 1e-5f) * (1.0f - lambda_init);
                bf16* op = ATT + (size_t)(b * SEQ + t) * D + h * 128;
#pragma unroll
                for (int i8 = 0; i8 < 16; ++i8) { const LAS float* xr = X + row * 129 + i8 * 8; v4u w; w.x = pk2(xr[0] * r, xr[1] * r); w.y = pk2(xr[2] * r, xr[3] * r); w.z = pk2(xr[4] * r, xr[5] * r); w.w = pk2(xr[6] * r, xr[7] * r); ((v4u*)op)[i8] = w; }
            }
            __syncthreads();
        }
}

__device__ __forceinline__ void moba_kmean(Frame& F, const bf16* K, float* KM) {
    const int gw = blockIdx.x * NWAVES + F.wave, NGW = F.G * NWAVES;
    for (int task = gw; task < BATCH * 16 * 16; task += NGW) {
        const int bh = task >> 4, n = task & 15; const bf16* kp = K + ((size_t)bh * SEQ + n * 256 + (F.lane >> 3)) * 64 + (F.lane & 7) * 8;
        float s[8];
#pragma unroll
        for (int e = 0; e < 8; ++e) s[e] = 0.f;
#pragma unroll
        for (int i = 0; i < 32; ++i) { const v4u w = *(const v4u*)(kp + (size_t)i * 8 * 64);
            s[0] += bflo(w.x); s[1] += bfhi(w.x); s[2] += bflo(w.y); s[3] += bfhi(w.y); s[4] += bflo(w.z); s[5] += bfhi(w.z); s[6] += bflo(w.w); s[7] += bfhi(w.w); }
#pragma unroll
        for (int e = 0; e < 8; ++e) { s[e] += __shfl_xor(s[e], 8); s[e] += __shfl_xor(s[e], 16); s[e] += __shfl_xor(s[e], 32); }
        if (F.lane < 8) { float* o = KM + (size_t)task * 64 + F.lane * 8;
            *(f32x4*)o = (f32x4){s[0], s[1], s[2], s[3]} * (1.0f / 256.0f); *(f32x4*)(o + 4) = (f32x4){s[4], s[5], s[6], s[7]} * (1.0f / 256.0f); }
    }
}
__device__ __forceinline__ void moba_attn_slow(Frame& F, const bf16* Q, const bf16* K, const bf16* V, const float* KM, bf16* ATT) {
    for (int wslot = blockIdx.x; wslot < 256; wslot += F.G)
        for (int i = 0; i < 4; ++i) {
            const int id = wslot * 4 + i, bhp = id >> 4, qb = qperm(id & 15), b = bhp >> 3, h = (bhp & 7) * 2 + (F.wave >> 2);
            const int row = F.tid & 255, t = qb * 256 + row;
            float q[64]; load_row64(Q + ((size_t)(b * 16 + h) * SEQ + t) * 64, q);
            const bf16* Kb = K + (size_t)(b * 16 + h) * SEQ * 64; const bf16* Vb = V + (size_t)(b * 16 + h) * SEQ * 64;
            const float* km = KM + (size_t)(b * 16 + h) * 16 * 64;
            unsigned bits = 0u;
            if (qb <= 3) bits = (1u << qb) - 1u;
            else {
                float v1 = -INFINITY, v2 = -INFINITY, v3 = -INFINITY; int i1 = 0, i2 = 0, i3 = 0;
                for (int n = 0; n < qb; ++n) {
                    float g0 = 0.f, g1 = 0.f;
#pragma unroll
                    for (int d = 0; d < 64; d += 2) { g0 += q[d] * km[n * 64 + d]; g1 += q[d + 1] * km[n * 64 + d + 1]; }
                    const float g = g0 + g1;
                    if (g > v1) { v3 = v2; i3 = i2; v2 = v1; i2 = i1; v1 = g; i1 = n; }
                    else if (g > v2) { v3 = v2; i3 = i2; v2 = g; i2 = n; }
                    else if (g > v3) { v3 = g; i3 = n; }
                }
                bits = (1u << i1) | (1u << i2) | (1u << i3);
            }
            float m = -INFINITY, l = 0.f; float o[64];
#pragma unroll
            for (int d = 0; d < 64; ++d) o[d] = 0.f;
            for (int n = 0; n < qb; ++n) {
                const bool sel = (bits >> n) & 1u;
                if (__any(sel)) for (int k = 0; k < 256; ++k) { const int key = n * 256 + k; attend_key<64>(q, Kb + (size_t)key * 64, Vb + (size_t)key * 64, sel, m, l, o); }
            }
            const int tmax = __builtin_amdgcn_readfirstlane(qb * 256 + (row | 63));
            for (int key = qb * 256; key <= tmax; ++key) attend_key<64>(q, Kb + (size_t)key * 64, Vb + (size_t)key * 64, key <= t, m, l, o);
            store_row_bf16<64>(ATT + (size_t)(b * SEQ + t) * D + h * 64, o, 1.0f / l);
        }
}

__device__ __forceinline__ void nsa_select_slow(Frame& F, const bf16* Q, const bf16* KC, unsigned long long* SEL) {
    LAS float* imp = (LAS float*)F.lds + F.tid * 65;
    for (int pass = blockIdx.x; pass < 256; pass += F.G) {
        const int id = pass * 2 + (F.wave >> 2), bg = id >> 4, qb = id & 15, b = bg >> 2, g = bg & 3;
        const int row = F.tid & 255, t = qb * 256 + row;
        for (int j = 0; j < 64; ++j) imp[j] = 0.f;
        const int nmax = t >= 31 ? (((t - 31) >> 4) < 254 ? ((t - 31) >> 4) : 254) : -1;
        const int tw = qb * 256 + (row | 63);
        const int wnmax = __builtin_amdgcn_readfirstlane(((tw - 31) >> 4) < 254 ? ((tw - 31) >> 4) : 254);
        const bf16* kc = KC + (size_t)(b * 4 + g) * 256 * 64;
        for (int r = 0; r < 4; ++r) {
            float q[64]; load_row64(Q + ((size_t)(b * 16 + g * 4 + r) * SEQ + t) * 64, q);
            float m = -INFINITY, l = 0.f;
            for (int n = 0; n <= wnmax; ++n) { const float s = dot64_bf(q, kc + n * 64); if (n <= nmax) { const float mn = fmaxf(m, s); l = l * ex2(m - mn) + ex2(s - mn); m = mn; } }
            const float il = l > 0.f ? 1.0f / l : 0.f;
            for (int n = 0; n <= wnmax; ++n) { const float s = dot64_bf(q, kc + n * 64);
                if (n <= nmax) { const float p = ex2(s - m) * il; imp[n >> 2] += p; if ((n & 3) == 3) imp[(n >> 2) + 1] += p; } }
        }
        const int qblk = t >> 6;
        unsigned long long bits;
        if (qblk < 16) bits = (2ull << qblk) - 1ull;
        else {
            bits = 1ull | (1ull << qblk) | (1ull << (qblk - 1));
            for (int it = 0; it < 13; ++it) {
                float best = -1.0f; int bi = 1;
                for (int j = 1; j <= qblk - 2; ++j) { const float v = imp[j]; if (!((bits >> j) & 1ull) && v > best) { best = v; bi = j; } }
                bits |= 1ull << bi;
            }
        }
        SEL[(size_t)(b * 4 + g) * SEQ + t] = bits;
    }
}
__device__ __forceinline__ void nsa_attn_slow(Frame& F, const bf16* Q, const bf16* KVC, const bf16* KS, const bf16* VS, const bf16* KW, const bf16* VW, const float* GATE, const unsigned long long* SEL, bf16* ATT) {
    for (int wslot = blockIdx.x; wslot < 256; wslot += F.G)
        for (int i = 0; i < 4; ++i) {
            const int id = wslot * 4 + i, bhp = id >> 4, qb = qperm(id & 15), b = bhp >> 3, h = (bhp & 7) * 2 + (F.wave >> 2), g = h >> 2;
            const int row = F.tid & 255, t = qb * 256 + row;
            float q[64]; load_row64(Q + ((size_t)(b * 16 + h) * SEQ + t) * 64, q);
            const float* gt = GATE + (size_t)(b * SEQ + t) * 48 + h * 3; const float g0 = gt[0], g1 = gt[1], g2 = gt[2];
            LAS float* ot = (LAS float*)F.lds + F.tid * 65; float o[64];
#pragma unroll
            for (int d = 0; d < 64; ++d) o[d] = 0.f;
            float m = -INFINITY, l = 0.f;
            {
                const int nmax = t >= 31 ? (((t - 31) >> 4) < 254 ? ((t - 31) >> 4) : 254) : -1;
                const int tw = qb * 256 + (row | 63);
                const int wnmax = __builtin_amdgcn_readfirstlane(((tw - 31) >> 4) < 254 ? ((tw - 31) >> 4) : 254);
                const bf16* kc = KVC + (size_t)(b * 4 + g) * 256 * 64; const bf16* vc = kc + (size_t)BATCH * 4 * 256 * 64;
#pragma unroll 1
                for (int n = 0; n <= wnmax; ++n) attend_key<64>(q, kc + n * 64, vc + n * 64, n <= nmax, m, l, o);
                const float w = l > 0.f ? g0 / l : 0.f;
#pragma unroll
                for (int d = 0; d < 64; ++d) { ot[d] = w * o[d]; o[d] = 0.f; }
                asm volatile("" ::: "memory");
            }
            {
                m = -INFINITY; l = 0.f;
                const unsigned long long bits = SEL[(size_t)(b * 4 + g) * SEQ + t];
                const bf16* kb = KS + (size_t)(b * 4 + g) * SEQ * 64; const bf16* vb = VS + (size_t)(b * 4 + g) * SEQ * 64;
                const int qblk = __builtin_amdgcn_readfirstlane(t >> 6);
#pragma unroll 1
                for (int j = 0; j <= qblk; ++j) {
                    const bool sel = (bits >> j) & 1ull;
                    if (__any(sel))
#pragma unroll 1
                    for (int k = 0; k < 64; ++k) { const int key = j * 64 + k; attend_key<64>(q, kb + (size_t)key * 64, vb + (size_t)key * 64, sel && key <= t, m, l, o); }
                }
                const float w = l > 0.f ? g1 / l : 0.f;
#pragma unroll
                for (int d = 0; d < 64; ++d) { ot[d] += w * o[d]; o[d] = 0.f; }
                asm volatile("" ::: "memory");
            }
            {
                m = -INFINITY; l = 0.f;
                const bf16* kb = KW + (size_t)(b * 4 + g) * SEQ * 64; const bf16* vb = VW + (size_t)(b * 4 + g) * SEQ * 64;
                const int tlo = (t & ~63) - 511, lo = __builtin_amdgcn_readfirstlane(tlo < 0 ? 0 : tlo), hi = __builtin_amdgcn_readfirstlane(t | 63);
#pragma unroll 1
                for (int key = lo; key <= hi; ++key) attend_key<64>(q, kb + (size_t)key * 64, vb + (size_t)key * 64, key <= t && key > t - 512, m, l, o);
                const float w = l > 0.f ? g2 / l : 0.f;
#pragma unroll
                for (int d = 0; d < 64; ++d) o[d] = ot[d] + w * o[d];
            }
            store_row_bf16<64>(ATT + (size_t)(b * SEQ + t) * D + h * 64, o, 1.0f);
        }
}


namespace fa {
typedef short bf16x8 __attribute__((ext_vector_type(8)));
typedef float f32x16 __attribute__((ext_vector_type(16)));
typedef short s16x4 __attribute__((ext_vector_type(4)));
typedef unsigned u32x4_t __attribute__((ext_vector_type(4)));
__device__ __forceinline__ int crow(int r, int hi) { return (r & 3) + 8 * (r >> 2) + 4 * hi; }
__device__ __forceinline__ float xmax(float x) { auto rr = __builtin_amdgcn_permlane32_swap(__float_as_uint(x), __float_as_uint(x), false, false); return fmaxf(__uint_as_float(rr[0]), __uint_as_float(rr[1])); }
__device__ __forceinline__ float xsum(float x) { auto rr = __builtin_amdgcn_permlane32_swap(__float_as_uint(x), __float_as_uint(x), false, false); return __uint_as_float(rr[0]) + __uint_as_float(rr[1]); }
__device__ __forceinline__ void dma16(const void* g, LAS unsigned char* l) {
    unsigned keep; const unsigned dst = (unsigned)__builtin_amdgcn_readfirstlane((unsigned)(uintptr_t)l);
    asm volatile("s_mov_b32 %0, m0\n\ts_mov_b32 m0, %2\n\ts_nop 0\n\tglobal_load_lds_dwordx4 %1, off\n\ts_mov_b32 m0, %0" : "=&s"(keep) : "v"(g), "s"(dst) : "memory");
}
__device__ __forceinline__ void dma16s(const void* sbase, unsigned voff, LAS unsigned char* l) {
    unsigned keep; const unsigned dst = (unsigned)__builtin_amdgcn_readfirstlane((unsigned)(uintptr_t)l);
    asm volatile("s_mov_b32 %0, m0\n\ts_mov_b32 m0, %3\n\ts_nop 0\n\tglobal_load_lds_dwordx4 %1, %2\n\ts_mov_b32 m0, %0" : "=&s"(keep) : "v"(voff), "s"(sbase), "s"(dst) : "memory");
}
__device__ __forceinline__ s16x4 vtr(const LAS unsigned char* p) { return __builtin_bit_cast(s16x4, __builtin_amdgcn_ds_read_tr16_b64_v4i16((LAS s16x4*)p)); }
__device__ __forceinline__ unsigned cvtpk(float lo, float hi) { unsigned r; asm volatile("v_cvt_pk_bf16_f32 %0, %1, %2" : "=v"(r) : "v"(lo), "v"(hi)); return r; }
#define FA_RINGBAR2(ahead) do { if ((ahead) >= 2) asm volatile("s_waitcnt vmcnt(4) lgkmcnt(0)" ::: "memory"); else if ((ahead) == 1) asm volatile("s_waitcnt vmcnt(2) lgkmcnt(0)" ::: "memory"); else asm volatile("s_waitcnt vmcnt(0) lgkmcnt(0)" ::: "memory"); \
    __builtin_amdgcn_s_barrier(); asm volatile("" ::: "memory"); } while (0)
#define FA_RINGBAR4(ahead) do { if ((ahead) >= 2) asm volatile("s_waitcnt vmcnt(8) lgkmcnt(0)" ::: "memory"); else if ((ahead) == 1) asm volatile("s_waitcnt vmcnt(4) lgkmcnt(0)" ::: "memory"); else asm volatile("s_waitcnt vmcnt(0) lgkmcnt(0)" ::: "memory"); \
    __builtin_amdgcn_s_barrier(); asm volatile("" ::: "memory"); } while (0)
#define FA_WAITBAR() do { asm volatile("s_waitcnt vmcnt(0) lgkmcnt(0)" ::: "memory"); __builtin_amdgcn_s_barrier(); asm volatile("" ::: "memory"); } while (0)

__device__ __forceinline__ void stage_k64(const bf16* kt, LAS unsigned char* dst, int wave, int lane) {
    const int k = wave * 8 + (lane >> 3), c = (lane & 7) ^ ((k >> 1) & 7);
    dma16(kt + (size_t)k * 64 + c * 8, dst + wave * 1024);
}
__device__ __forceinline__ void stage_v64(const bf16* vt, LAS unsigned char* dst, int wave, int lane) { dma16(vt + (size_t)(16 * (wave & 3) + (lane >> 2)) * 64 + 32 * (wave >> 2) + 8 * (lane & 3), dst + wave * 1024); }

__device__ __forceinline__ void edge_mask(f32x16& p0, f32x16& p1, int lim_lo, int lim_hi, int hi) {
    int ll = lim_lo - 4 * hi, lh = lim_hi - 4 * hi;
    asm volatile("" : "+v"(ll), "+v"(lh));
#pragma unroll
    for (int r = 0; r < 16; ++r) { const int k0 = (r & 3) + 8 * (r >> 2); if (k0 > lh || k0 <= ll) p0[r] = -INFINITY; if (k0 + 32 > lh || k0 + 32 <= ll) p1[r] = -INFINITY; }
}
__device__ __forceinline__ void scores_c(const LAS unsigned char* Kt, const bf16x8 (&qr)[4], const f32x16& c, f32x16& p0, f32x16& p1, int lane) {
    const int k = lane & 31, hi = lane >> 5, sw = (k >> 1) & 7;
    const LAS unsigned char* kb = Kt + k * 128;
    bf16x8 a0[4], a1[4];
#pragma unroll
    for (int d0 = 0; d0 < 4; ++d0) { const int off = ((2 * d0 + hi) ^ sw) * 16; a0[d0] = *(const LAS bf16x8*)(kb + off); a1[d0] = *(const LAS bf16x8*)(kb + 4096 + off); }
    p0 = __builtin_amdgcn_mfma_f32_32x32x16_bf16(a0[0], qr[0], c, 0, 0, 0); p1 = __builtin_amdgcn_mfma_f32_32x32x16_bf16(a1[0], qr[0], c, 0, 0, 0);
#pragma unroll
    for (int d0 = 1; d0 < 4; ++d0) { p0 = __builtin_amdgcn_mfma_f32_32x32x16_bf16(a0[d0], qr[d0], p0, 0, 0, 0); p1 = __builtin_amdgcn_mfma_f32_32x32x16_bf16(a1[d0], qr[d0], p1, 0, 0, 0); }
}
__device__ __forceinline__ void scores(const LAS unsigned char* Kt, const bf16x8 (&qr)[4], f32x16& p0, f32x16& p1, int lane) {
    f32x16 z;
#pragma unroll
    for (int r = 0; r < 16; ++r) z[r] = 0.f;
    scores_c(Kt, qr, z, p0, p1, lane);
}
__device__ __forceinline__ float max3f(float a, float b, float c) { float r; asm("v_max3_f32 %0, %1, %2, %3" : "=v"(r) : "v"(a), "v"(b), "v"(c)); return r; }
__device__ __forceinline__ float rowmax32(const f32x16& p0, const f32x16& p1) {
    float a = max3f(p0[0], p0[1], p1[0]), b = max3f(p0[2], p0[3], p1[1]); a = max3f(a, p1[2], p1[3]);
#pragma unroll
    for (int r = 4; r < 16; r += 4) { a = max3f(a, p0[r], p0[r + 1]); b = max3f(b, p0[r + 2], p0[r + 3]); a = max3f(a, p1[r], p1[r + 1]); b = max3f(b, p1[r + 2], p1[r + 3]); }
    return xmax(fmaxf(a, b));
}
template <int NDB>
__device__ __forceinline__ void vfrag(const LAS unsigned char* vb, int s, bf16x8 (&vf)[NDB]) {
#pragma unroll
    for (int db = 0; db < NDB; ++db) { const s16x4 lo = vtr(vb + db * 4096 + s * 1024), hi4 = vtr(vb + db * 4096 + s * 1024 + 512); vf[db] = (bf16x8){lo[0], lo[1], lo[2], lo[3], hi4[0], hi4[1], hi4[2], hi4[3]}; }
}
template <int NDB>
__device__ __forceinline__ void pv(const LAS unsigned char* Vt, const bf16x8 (&pw)[4], f32x16 (&o)[NDB], int lane) {
    const LAS unsigned char* vb = Vt + ((lane >> 4) & 1) * 32 + (lane & 3) * 8 + (4 * (lane >> 5) + ((lane & 15) >> 2)) * 64;
    bf16x8 va[NDB], vbq[NDB];
    vfrag<NDB>(vb, 0, va);
    vfrag<NDB>(vb, 1, vbq);
    __builtin_amdgcn_sched_barrier(0);
#pragma unroll
    for (int db = 0; db < NDB; ++db) o[db] = __builtin_amdgcn_mfma_f32_32x32x16_bf16(va[db], pw[0], o[db], 0, 0, 0);
    vfrag<NDB>(vb, 2, va);
    __builtin_amdgcn_sched_barrier(0);
#pragma unroll
    for (int db = 0; db < NDB; ++db) o[db] = __builtin_amdgcn_mfma_f32_32x32x16_bf16(vbq[db], pw[1], o[db], 0, 0, 0);
    vfrag<NDB>(vb, 3, vbq);
    __builtin_amdgcn_sched_barrier(0);
#pragma unroll
    for (int db = 0; db < NDB; ++db) o[db] = __builtin_amdgcn_mfma_f32_32x32x16_bf16(va[db], pw[2], o[db], 0, 0, 0);
#pragma unroll
    for (int db = 0; db < NDB; ++db) o[db] = __builtin_amdgcn_mfma_f32_32x32x16_bf16(vbq[db], pw[3], o[db], 0, 0, 0);
    __builtin_amdgcn_sched_barrier(0);
}
__device__ __forceinline__ void pack_p(const f32x16& p0, const f32x16& p1, bf16x8 (&pw)[4]) {
    typedef unsigned u4 __attribute__((ext_vector_type(4)));
    const u4 w0 = {cvtpk(p0[0], p0[1]), cvtpk(p0[2], p0[3]), cvtpk(p0[4], p0[5]), cvtpk(p0[6], p0[7])}, w1 = {cvtpk(p0[8], p0[9]), cvtpk(p0[10], p0[11]), cvtpk(p0[12], p0[13]), cvtpk(p0[14], p0[15])};
    const u4 w2 = {cvtpk(p1[0], p1[1]), cvtpk(p1[2], p1[3]), cvtpk(p1[4], p1[5]), cvtpk(p1[6], p1[7])}, w3 = {cvtpk(p1[8], p1[9]), cvtpk(p1[10], p1[11]), cvtpk(p1[12], p1[13]), cvtpk(p1[14], p1[15])};
    pw[0] = __builtin_bit_cast(bf16x8, w0); pw[1] = __builtin_bit_cast(bf16x8, w1); pw[2] = __builtin_bit_cast(bf16x8, w2); pw[3] = __builtin_bit_cast(bf16x8, w3);
}
constexpr float FA_THR = 8.0f;
struct RowState { f32x16 negm; float mref, l; bool seen; };
__device__ __forceinline__ void row_init(RowState& s) { s.mref = 0.f; s.l = 0.f; s.seen = false;
#pragma unroll
    for (int r = 0; r < 16; ++r) s.negm[r] = 0.f; }
template <int NDB>
__device__ __forceinline__ void attn_tile(const LAS unsigned char* Kt, const LAS unsigned char* Vt, const bf16x8 (&qr)[4], RowState& st, f32x16 (&o)[NDB], bool edge, int lim_lo, int lim_hi, bool use_keep, bool keep, int lane) {
    f32x16 p0, p1;
    if (use_keep) { f32x16 c;
#pragma unroll
        for (int r = 0; r < 16; ++r) c[r] = keep ? st.negm[r] : -INFINITY;
        scores_c(Kt, qr, c, p0, p1, lane);
    } else scores_c(Kt, qr, st.negm, p0, p1, lane);
    if (edge) edge_mask(p0, p1, lim_lo, lim_hi, lane >> 5);
    const float mx = rowmax32(p0, p1);
    const bool vis = mx > -INFINITY, cond = (mx > FA_THR) || (!st.seen && vis);
    if (__any(cond)) {
        const float dl = cond ? mx : 0.f, alpha = st.seen ? ex2(-dl) : 1.0f;
        st.mref += dl; st.l *= alpha;
#pragma unroll
        for (int r = 0; r < 16; ++r) { p0[r] -= dl; p1[r] -= dl; st.negm[r] = -st.mref; }
#pragma unroll
        for (int db = 0; db < NDB; ++db)
#pragma unroll
            for (int r = 0; r < 16; ++r) o[db][r] *= alpha;
    }
    st.seen = st.seen || vis;
    float ps0 = 0.f, ps1 = 0.f;
#pragma unroll
    for (int r = 0; r < 16; ++r) { p0[r] = ex2(p0[r]); p1[r] = ex2(p1[r]); ps0 += p0[r]; ps1 += p1[r]; }
    st.l += ps0 + ps1;
    bf16x8 pw[4]; pack_p(p0, p1, pw);
    __builtin_amdgcn_sched_barrier(0);
    pv<NDB>(Vt, pw, o, lane);
    __builtin_amdgcn_sched_barrier(0);
}
template <int NDB>
__device__ __forceinline__ void store_ot(bf16* rowp, const f32x16 (&o)[NDB], float sc, int hi) {
    typedef unsigned u2 __attribute__((ext_vector_type(2)));
#pragma unroll
    for (int db = 0; db < NDB; ++db)
#pragma unroll
        for (int rq = 0; rq < 4; ++rq) { u2 w; w.x = cvtpk(o[db][4 * rq] * sc, o[db][4 * rq + 1] * sc); w.y = cvtpk(o[db][4 * rq + 2] * sc, o[db][4 * rq + 3] * sc);
            *(u2*)(rowp + 32 * db + 8 * rq + 4 * hi) = w; }
}
struct RowState2 { float mref, l; bool seen; };
__device__ __forceinline__ void row_init2(RowState2& s) { s.mref = 0.f; s.l = 0.f; s.seen = false; }
__device__ __forceinline__ void scores2(const LAS unsigned char* Kt, const bf16x8 (&qa)[4], const bf16x8 (&qb)[4], float cA, float cB, f32x16& a0p, f32x16& a1p, f32x16& b0p, f32x16& b1p, int lane) {
    const int k = lane & 31, hi = lane >> 5, sw = (k >> 1) & 7;
    const LAS unsigned char* kb = Kt + k * 128;
    bf16x8 x0, x1, y0, y1;
    { const int off = ((0 + hi) ^ sw) * 16; x0 = *(const LAS bf16x8*)(kb + off); x1 = *(const LAS bf16x8*)(kb + 4096 + off); }
    { const int off = ((2 + hi) ^ sw) * 16; y0 = *(const LAS bf16x8*)(kb + off); y1 = *(const LAS bf16x8*)(kb + 4096 + off); }
    f32x16 c;
#pragma unroll
    for (int r = 0; r < 16; ++r) c[r] = cA;
    a0p = __builtin_amdgcn_mfma_f32_32x32x16_bf16(x0, qa[0], c, 0, 0, 0); a1p = __builtin_amdgcn_mfma_f32_32x32x16_bf16(x1, qa[0], c, 0, 0, 0);
#pragma unroll
    for (int r = 0; r < 16; ++r) c[r] = cB;
    b0p = __builtin_amdgcn_mfma_f32_32x32x16_bf16(x0, qb[0], c, 0, 0, 0); b1p = __builtin_amdgcn_mfma_f32_32x32x16_bf16(x1, qb[0], c, 0, 0, 0);
    __builtin_amdgcn_sched_barrier(0);
    { const int off = ((4 + hi) ^ sw) * 16; x0 = *(const LAS bf16x8*)(kb + off); x1 = *(const LAS bf16x8*)(kb + 4096 + off); }
    a0p = __builtin_amdgcn_mfma_f32_32x32x16_bf16(y0, qa[1], a0p, 0, 0, 0); a1p = __builtin_amdgcn_mfma_f32_32x32x16_bf16(y1, qa[1], a1p, 0, 0, 0);
    b0p = __builtin_amdgcn_mfma_f32_32x32x16_bf16(y0, qb[1], b0p, 0, 0, 0); b1p = __builtin_amdgcn_mfma_f32_32x32x16_bf16(y1, qb[1], b1p, 0, 0, 0);
    __builtin_amdgcn_sched_barrier(0);
    { const int off = ((6 + hi) ^ sw) * 16; y0 = *(const LAS bf16x8*)(kb + off); y1 = *(const LAS bf16x8*)(kb + 4096 + off); }
    a0p = __builtin_amdgcn_mfma_f32_32x32x16_bf16(x0, qa[2], a0p, 0, 0, 0); a1p = __builtin_amdgcn_mfma_f32_32x32x16_bf16(x1, qa[2], a1p, 0, 0, 0);
    b0p = __builtin_amdgcn_mfma_f32_32x32x16_bf16(x0, qb[2], b0p, 0, 0, 0); b1p = __builtin_amdgcn_mfma_f32_32x32x16_bf16(x1, qb[2], b1p, 0, 0, 0);
    __builtin_amdgcn_sched_barrier(0);
    a0p = __builtin_amdgcn_mfma_f32_32x32x16_bf16(y0, qa[3], a0p, 0, 0, 0); a1p = __builtin_amdgcn_mfma_f32_32x32x16_bf16(y1, qa[3], a1p, 0, 0, 0);
    b0p = __builtin_amdgcn_mfma_f32_32x32x16_bf16(y0, qb[3], b0p, 0, 0, 0); b1p = __builtin_amdgcn_mfma_f32_32x32x16_bf16(y1, qb[3], b1p, 0, 0, 0);
    __builtin_amdgcn_sched_barrier(0);
}
template <int NDB>
__device__ __forceinline__ void softmax_pack(f32x16& p0, f32x16& p1, RowState2& st, f32x16 (&o)[NDB], bf16x8 (&pw)[4], bool edge, int lim_lo, int lim_hi, int lane) {
    if (edge) edge_mask(p0, p1, lim_lo, lim_hi, lane >> 5);
    const float mx = rowmax32(p0, p1);
    const bool vis = mx > -INFINITY, cond = (mx > FA_THR) || (!st.seen && vis);
    if (__any(cond)) {
        const float dl = cond ? mx : 0.f, alpha = st.seen ? ex2(-dl) : 1.0f;
        st.mref += dl; st.l *= alpha;
#pragma unroll
        for (int r = 0; r < 16; ++r) { p0[r] -= dl; p1[r] -= dl; }
#pragma unroll
        for (int db = 0; db < NDB; ++db)
#pragma unroll
            for (int r = 0; r < 16; ++r) o[db][r] *= alpha;
    }
    st.seen = st.seen || vis;
    float ps0 = 0.f, ps1 = 0.f;
#pragma unroll
    for (int r = 0; r < 16; ++r) { p0[r] = ex2(p0[r]); p1[r] = ex2(p1[r]); ps0 += p0[r]; ps1 += p1[r]; }
    st.l += ps0 + ps1;
    pack_p(p0, p1, pw);
}
__device__ __forceinline__ void pv2(const LAS unsigned char* Vt, const bf16x8 (&pa)[4], const bf16x8 (&pb)[4], f32x16 (&oa)[2], f32x16 (&ob)[2], int lane) {
    const LAS unsigned char* vb = Vt + ((lane >> 4) & 1) * 32 + (lane & 3) * 8 + (4 * (lane >> 5) + ((lane & 15) >> 2)) * 64;
#pragma unroll
    for (int s = 0; s < 4; ++s) {
        bf16x8 va[2];
        vfrag<2>(vb, s, va);
        __builtin_amdgcn_sched_barrier(0);
#pragma unroll
        for (int db = 0; db < 2; ++db) { oa[db] = __builtin_amdgcn_mfma_f32_32x32x16_bf16(va[db], pa[s], oa[db], 0, 0, 0); ob[db] = __builtin_amdgcn_mfma_f32_32x32x16_bf16(va[db], pb[s], ob[db], 0, 0, 0); }
        __builtin_amdgcn_sched_barrier(0);
    }
}
}

__device__ __forceinline__ void diff_attn_fast(Frame& F, const bf16* Q, const bf16* K, const bf16* V, bf16* ATT, float lam, float lambda_init, const float* subln) {
    using namespace fa;
    int lane_ = F.lane; asm volatile("" : "+v"(lane_));
    const int lane = lane_, wave = F.wave, r32 = lane & 31, hi = lane >> 5, c = wave >> 2, w = wave & 3;
    LAS unsigned char* L = F.lds;
    LAS float* SGL = (LAS float*)(L + 131072);
    if (F.tid < 128) SGL[F.tid] = subln[F.tid];
    for (int slot = F.vcu; slot < 256; slot += F.G)
        for (int i = 0; i < 8; ++i) {
            const int bh = (slot >> 5) * 8 + (i >> 1) * 2 + ((slot >> 4) & 1), pq = slot & 15, qb = (i & 1) ? 31 - pq : pq, b = bh >> 3, h = bh & 7;
            const int t = qb * 128 + w * 32 + r32;
            const bf16* Qp = Q + ((size_t)(b * 16 + h * 2 + c) * SEQ + t) * 64 + hi * 8;
            bf16x8 qr[4];
#pragma unroll
            for (int d0 = 0; d0 < 4; ++d0) qr[d0] = *(const bf16x8*)(Qp + d0 * 16);
            asm volatile("" : "+v"(qr[0]), "+v"(qr[1]), "+v"(qr[2]), "+v"(qr[3]));
            const bf16* K0 = K + (size_t)(b * 16 + h * 2) * SEQ * 64; const bf16* K1 = K0 + (size_t)SEQ * 64; const bf16* Vb = V + (size_t)(b * 8 + h) * SEQ * 128;
            const int nt = 2 * qb + 2, tl = 2 * qb + (w >> 1);
            f32x16 o[4]; RowState st; row_init(st);
#pragma unroll
            for (int db = 0; db < 4; ++db)
#pragma unroll
                for (int r = 0; r < 16; ++r) o[db][r] = 0.f;
#define DIFF_STAGE(j, buf) do { LAS unsigned char* B_ = L + (buf) * 32768; \
                stage_k64(K0 + (size_t)(j) * 4096, B_, wave, lane); stage_k64(K1 + (size_t)(j) * 4096, B_ + 8192, wave, lane); \
                _Pragma("unroll") for (int pp_ = 0; pp_ < 2; ++pp_) { const int pi_ = wave + 8 * pp_; \
                    dma16(Vb + (size_t)((j) * 64 + 16 * (pi_ & 3) + (lane >> 2)) * 128 + 32 * (pi_ >> 2) + 8 * (lane & 3), B_ + 16384 + pi_ * 1024); } } while (0)
            for (int jj = 0; jj < 3 && jj < nt; ++jj) DIFF_STAGE(jj, jj);
            for (int j = 0; j < nt; ++j) {
                const int ahead = nt - 1 - j;
                FA_RINGBAR4(ahead);
                if (j + 3 < nt) DIFF_STAGE(j + 3, (j + 3) & 3);
                if (j <= tl) {
                    const LAS unsigned char* B = L + (j & 3) * 32768;
                    attn_tile<4>(B + c * 8192, B + 16384, qr, st, o, j == tl, -1, t - j * 64, false, true, lane);
                }
            }
#undef DIFF_STAGE
            FA_WAITBAR();
            const float inv = 1.0f / xsum(st.l);
            LAS float* X = (LAS float*)L + (size_t)(w * 64) * 64 + lane;
            if (c == 1) {
#pragma unroll
                for (int db = 0; db < 4; ++db)
#pragma unroll
                    for (int r = 0; r < 16; ++r) X[(db * 16 + r) * 64] = o[db][r] * inv * lam;
            }
            FA_WAITBAR();
            if (c == 0) {
                float ss = 0.f;
#pragma unroll
                for (int db = 0; db < 4; ++db)
#pragma unroll
                    for (int r = 0; r < 16; ++r) { const float a = o[db][r] * inv - X[(db * 16 + r) * 64]; o[db][r] = a; ss += a * a; }
                ss = xsum(ss);
                const float rr = __builtin_amdgcn_rsqf(ss * (1.0f / 128.0f) + 1e-5f) * (1.0f - lambda_init);
                bf16* rowp = ATT + (size_t)(b * SEQ + t) * D + h * 128;
                typedef unsigned u2 __attribute__((ext_vector_type(2)));
#pragma unroll
                for (int db = 0; db < 4; ++db)
#pragma unroll
                    for (int rq = 0; rq < 4; ++rq) { const f32x4 sg = *(const LAS f32x4*)(SGL + 32 * db + 8 * rq + 4 * hi);
                        u2 wv; wv.x = cvtpk(o[db][4 * rq] * rr * sg[0], o[db][4 * rq + 1] * rr * sg[1]); wv.y = cvtpk(o[db][4 * rq + 2] * rr * sg[2], o[db][4 * rq + 3] * rr * sg[3]);
                        *(u2*)(rowp + 32 * db + 8 * rq + 4 * hi) = wv; }
            }
            FA_WAITBAR();
        }
}

namespace fa {
#define FA_PIN(x) asm volatile("" : "+v"(x))
struct PipeState { f32x16 negm; float l, alpha; };
template <bool HAS_NEXT>
__device__ __forceinline__ void diff_step(const LAS unsigned char* Kn, const LAS unsigned char* Vt, const bf16x8 (&qr)[4], f32x16& c0, f32x16& c1, f32x16& n0, f32x16& n1, PipeState& st, f32x16 (&o)[4],
                                          bool edge_next, int lim_hi_next, int lane) {
    const int k = lane & 31, hi = lane >> 5, sw = (k >> 1) & 7;
    if (__any(st.alpha != 1.0f)) {
#pragma unroll
        for (int db = 0; db < 4; ++db)
#pragma unroll
            for (int r = 0; r < 16; ++r) o[db][r] *= st.alpha;
        st.alpha = 1.0f;
    }
    u32x4_t pwv[4]; float ps = 0.f;
    const unsigned ka = (unsigned)(uintptr_t)Kn + (unsigned)(k * 128 + (hi ^ sw) * 16);
#define KFRAG(d0, half) (*(const LAS bf16x8*)(uintptr_t)((ka ^ (32u * (d0))) + 4096u * (half)))
    if constexpr (HAS_NEXT) {
        bf16x8 x0 = KFRAG(0, 0), y0 = KFRAG(1, 0);
        __builtin_amdgcn_sched_barrier(0);
#pragma unroll
        for (int g = 0; g < 4; ++g) {
            if (g == 0) n0 = __builtin_amdgcn_mfma_f32_32x32x16_bf16(x0, qr[0], st.negm, 0, 0, 0);
            else if (g == 1) n0 = __builtin_amdgcn_mfma_f32_32x32x16_bf16(y0, qr[1], n0, 0, 0, 0);
            else if (g == 2) n0 = __builtin_amdgcn_mfma_f32_32x32x16_bf16(x0, qr[2], n0, 0, 0, 0);
            else n0 = __builtin_amdgcn_mfma_f32_32x32x16_bf16(y0, qr[3], n0, 0, 0, 0);
            if (g == 0) x0 = KFRAG(2, 0);
            if (g == 1) y0 = KFRAG(3, 0);
#pragma unroll
            for (int e = 0; e < 4; ++e) c0[4 * g + e] = ex2(c0[4 * g + e]);
            ps += (c0[4 * g] + c0[4 * g + 1]) + (c0[4 * g + 2] + c0[4 * g + 3]);
            pwv[g >> 1][2 * (g & 1)] = cvtpk(c0[4 * g], c0[4 * g + 1]); pwv[g >> 1][2 * (g & 1) + 1] = cvtpk(c0[4 * g + 2], c0[4 * g + 3]);
            FA_PIN(pwv[g >> 1]); FA_PIN(ps);
            __builtin_amdgcn_sched_barrier(0);
        }
    } else {
#pragma unroll
        for (int g = 0; g < 8; ++g) { c0[2 * g] = ex2(c0[2 * g]); c0[2 * g + 1] = ex2(c0[2 * g + 1]); ps += c0[2 * g] + c0[2 * g + 1]; pwv[g >> 2][g & 3] = cvtpk(c0[2 * g], c0[2 * g + 1]); }
    }
    const LAS unsigned char* vb = Vt + ((lane >> 4) & 1) * 32 + (lane & 3) * 8 + (4 * (lane >> 5) + ((lane & 15) >> 2)) * 64;
#define FA_VF(m) ({ const s16x4 lo_ = vtr(vb + ((m) & 3) * 4096 + ((m) >> 2) * 1024), hi_ = vtr(vb + ((m) & 3) * 4096 + ((m) >> 2) * 1024 + 512); (bf16x8){lo_[0], lo_[1], lo_[2], lo_[3], hi_[0], hi_[1], hi_[2], hi_[3]}; })
    bf16x8 vf[5];
#pragma unroll
    for (int m = 0; m < 5; ++m) vf[m] = FA_VF(m);
    __builtin_amdgcn_sched_barrier(0);
#pragma unroll
    for (int m = 0; m < 8; ++m) {
        const int sl = m >> 2, db = m & 3;
        o[db] = __builtin_amdgcn_mfma_f32_32x32x16_bf16(vf[m % 5], __builtin_bit_cast(bf16x8, pwv[sl]), o[db], 0, 0, 0);
        vf[m % 5] = FA_VF(m + 5);
        c1[2 * m] = ex2(c1[2 * m]); c1[2 * m + 1] = ex2(c1[2 * m + 1]); ps += c1[2 * m] + c1[2 * m + 1]; pwv[2 + sl][db] = cvtpk(c1[2 * m], c1[2 * m + 1]); FA_PIN(pwv[2 + sl]); FA_PIN(ps);
        __builtin_amdgcn_sched_barrier(0);
    }
    st.l += ps;
    if constexpr (HAS_NEXT) {
        bf16x8 x1 = KFRAG(0, 1), y1 = KFRAG(1, 1);
        __builtin_amdgcn_sched_barrier(0);
        n1 = __builtin_amdgcn_mfma_f32_32x32x16_bf16(x1, qr[0], st.negm, 0, 0, 0);
        x1 = KFRAG(2, 1);
        __builtin_amdgcn_sched_barrier(0);
        n1 = __builtin_amdgcn_mfma_f32_32x32x16_bf16(y1, qr[1], n1, 0, 0, 0);
        y1 = KFRAG(3, 1);
        __builtin_amdgcn_sched_barrier(0);
        n1 = __builtin_amdgcn_mfma_f32_32x32x16_bf16(x1, qr[2], n1, 0, 0, 0);
        n1 = __builtin_amdgcn_mfma_f32_32x32x16_bf16(y1, qr[3], n1, 0, 0, 0);
    }
    __builtin_amdgcn_sched_barrier(0);
    float mx = 0.f;
#pragma unroll
    for (int m = 8; m < 16; ++m) {
        const int sl = m >> 2, db = m & 3;
        o[db] = __builtin_amdgcn_mfma_f32_32x32x16_bf16(vf[m % 5], __builtin_bit_cast(bf16x8, pwv[sl]), o[db], 0, 0, 0);
        if (m + 5 < 16) vf[m % 5] = FA_VF(m + 5);
        if (m == 11) { if constexpr (HAS_NEXT) { if (edge_next) edge_mask(n0, n1, -1, lim_hi_next, hi); mx = rowmax32(n0, n1); FA_PIN(mx); } }
        if (m == 9 || m == 11 || m == 15) __builtin_amdgcn_sched_barrier(0);
    }
#undef FA_VF
    if constexpr (HAS_NEXT) {
        const bool cond = mx > FA_THR;
        if (__any(cond)) {
            const float dl = cond ? mx : 0.f, nm = st.negm[0] - dl; st.alpha = ex2(-dl); st.l *= st.alpha;
#pragma unroll
            for (int r = 0; r < 16; ++r) { n0[r] -= dl; n1[r] -= dl; st.negm[r] = nm; }
        }
    }
}
#undef KFRAG
}
__device__ __forceinline__ void diff_attn_pipe(Frame& F, const bf16* Q, const bf16* K, const bf16* V, bf16* ATT, float lam, float lambda_init, const float* subln) {
    using namespace fa;
    const int wave = F.wave, c = wave >> 2, w = wave & 3;
    LAS unsigned char* L = F.lds;
    LAS float* SGL = (LAS float*)(L + 131072);
    if (F.tid < 128) SGL[F.tid] = subln[F.tid];
    for (int slot = F.vcu; slot < 256; slot += F.G)
        for (int i = 0; i < 8; ++i) {
            int lane_ = F.lane; asm volatile("" : "+v"(lane_));
            const int lane = lane_, r32 = lane & 31, hi = lane >> 5;
            const int kk_ = wave * 8 + (lane >> 3);
            const unsigned voffK = (unsigned)(kk_ * 64 + (((lane & 7) ^ ((kk_ >> 1) & 7)) * 8)) * 2u;
            const unsigned voffV0 = (unsigned)((16 * (wave & 3) + (lane >> 2)) * 128 + 32 * (wave >> 2) + 8 * (lane & 3)) * 2u, voffV1 = voffV0 + 64u * 2u;
            const int bh = (slot >> 5) * 8 + (i >> 1) * 2 + ((slot >> 4) & 1), pq = slot & 15, qb = (i & 1) ? 31 - pq : pq, b = bh >> 3, h = bh & 7;
            const int t = qb * 128 + w * 32 + r32;
            int lq = lane; asm volatile("" : "+v"(lq));
            const bf16* Qp = Q + ((size_t)(b * 16 + h * 2 + c) * SEQ + qb * 128 + w * 32 + (lq & 31)) * 64 + (lq >> 5) * 8;
            bf16x8 qr[4];
#pragma unroll
            for (int d0 = 0; d0 < 4; ++d0) qr[d0] = *(const bf16x8*)(Qp + d0 * 16);
            asm volatile("" : "+v"(qr[0]), "+v"(qr[1]), "+v"(qr[2]), "+v"(qr[3]));
            const bf16* K0 = K + (size_t)(b * 16 + h * 2) * SEQ * 64; const bf16* K1 = K0 + (size_t)SEQ * 64; const bf16* Vb = V + (size_t)(b * 8 + h) * SEQ * 128;
            const int nt = 2 * qb + 2;
            f32x16 o[4]; PipeState st; st.l = 0.f; st.alpha = 1.f;
#pragma unroll
            for (int db = 0; db < 4; ++db)
#pragma unroll
                for (int r = 0; r < 16; ++r) o[db][r] = 0.f;
#define DIFF_STAGE(j, buf) do { LAS unsigned char* B_ = L + (buf) * 32768; \
                dma16s(K0 + (size_t)(j) * 4096, voffK, B_ + wave * 1024); dma16s(K1 + (size_t)(j) * 4096, voffK, B_ + 8192 + wave * 1024); \
                dma16s(Vb + (size_t)(j) * 8192, voffV0, B_ + 16384 + wave * 1024); dma16s(Vb + (size_t)(j) * 8192, voffV1, B_ + 16384 + (wave + 8) * 1024); } while (0)
            for (int jj = 0; jj < 3 && jj < nt; ++jj) DIFF_STAGE(jj, jj);
            FA_RINGBAR4(nt - 1);
            f32x16 sa0, sa1, sb0, sb1;
            {
                scores(L + c * 8192, qr, sa0, sa1, lane);
                if (nt == 2) edge_mask(sa0, sa1, -1, t, hi);
                const float mx = rowmax32(sa0, sa1);
#pragma unroll
                for (int r = 0; r < 16; ++r) { sa0[r] -= mx; sa1[r] -= mx; st.negm[r] = -mx; }
            }
            for (int j = 0; j < nt - 2; j += 2) {
                FA_RINGBAR4(1);
                if (j + 3 < nt) DIFF_STAGE(j + 3, (j + 3) & 3);
                diff_step<true>(L + ((j + 1) & 3) * 32768 + c * 8192, L + (j & 3) * 32768 + 16384, qr, sa0, sa1, sb0, sb1, st, o, j + 1 >= nt - 2, t - (j + 1) * 64, lane);
                FA_RINGBAR4((nt - 2 - j >= 2) ? 1 : 0);
                if (j + 4 < nt) DIFF_STAGE(j + 4, (j + 4) & 3);
                diff_step<true>(L + ((j + 2) & 3) * 32768 + c * 8192, L + ((j + 1) & 3) * 32768 + 16384, qr, sb0, sb1, sa0, sa1, st, o, j + 2 >= nt - 2, t - (j + 2) * 64, lane);
            }
            {
                const int j = nt - 2;
                FA_RINGBAR4(0);
                diff_step<true>(L + ((j + 1) & 3) * 32768 + c * 8192, L + (j & 3) * 32768 + 16384, qr, sa0, sa1, sb0, sb1, st, o, true, t - (j + 1) * 64, lane);
                diff_step<false>(L, L + ((j + 1) & 3) * 32768 + 16384, qr, sb0, sb1, sa0, sa1, st, o, false, 0, lane);
            }
#undef DIFF_STAGE
            FA_WAITBAR();
            if (__any(st.alpha != 1.0f)) {
#pragma unroll
                for (int db = 0; db < 4; ++db)
#pragma unroll
                    for (int r = 0; r < 16; ++r) o[db][r] *= st.alpha;
            }
            const float inv = 1.0f / xsum(st.l);
            int le = lane; asm volatile("" : "+v"(le));
            const int hie = le >> 5, te = qb * 128 + w * 32 + (le & 31);
            LAS float* X = (LAS float*)L + (size_t)(w * 64) * 64 + le;
            if (c == 1) {
#pragma unroll
                for (int db = 0; db < 4; ++db)
#pragma unroll
                    for (int r = 0; r < 16; ++r) X[(db * 16 + r) * 64] = o[db][r] * inv * lam;
            }
            FA_WAITBAR();
            if (c == 0) {
                float ss = 0.f;
#pragma unroll
                for (int db = 0; db < 4; ++db)
#pragma unroll
                    for (int r = 0; r < 16; ++r) { const float a = o[db][r] * inv - X[(db * 16 + r) * 64]; o[db][r] = a; ss += a * a; }
                ss = xsum(ss);
                const float rr = __builtin_amdgcn_rsqf(ss * (1.0f / 128.0f) + 1e-5f) * (1.0f - lambda_init);
                bf16* rowp = ATT + (size_t)(b * SEQ + te) * D + h * 128;
                typedef unsigned u2 __attribute__((ext_vector_type(2)));
#pragma unroll
                for (int db = 0; db < 4; ++db)
#pragma unroll
                    for (int rq = 0; rq < 4; ++rq) { const f32x4 sg = *(const LAS f32x4*)(SGL + 32 * db + 8 * rq + 4 * hie);
                        u2 wv; wv.x = cvtpk(o[db][4 * rq] * rr * sg[0], o[db][4 * rq + 1] * rr * sg[1]); wv.y = cvtpk(o[db][4 * rq + 2] * rr * sg[2], o[db][4 * rq + 3] * rr * sg[3]);
                        *(u2*)(rowp + 32 * db + 8 * rq + 4 * hie) = wv; }
            }
            FA_WAITBAR();
        }
}

__device__ __forceinline__ void moba_attn_fast(Frame& F, const bf16* Q, const bf16* K, const bf16* V, const float* KM, bf16* ATT) {
    using namespace fa;
    int lane_ = F.lane; asm volatile("" : "+v"(lane_));
    const int lane = lane_, wave = F.wave, r32 = lane & 31, hi = lane >> 5;
    LAS unsigned char* L = F.lds;
    LAS unsigned* bitsL = (LAS unsigned*)(L + 65536);
    LAS int* TL = (LAS int*)(L + 65536 + 2048);
    for (int slot = F.vcu; slot < 256; slot += F.G)
        for (int i = 0; i < 8; ++i) {
            const int bh = (slot >> 2) * 2 + (i >> 2), qd = slot & 3, i4 = i & 3, cb = i4 == 0 ? qd : (i4 == 1 ? 15 - qd : (i4 == 2 ? 8 + qd : 7 - qd)), b = bh >> 4, h = bh & 15;
            const bf16* Qb = Q + (size_t)(b * 16 + h) * SEQ * 64; const bf16* Kb = K + (size_t)(b * 16 + h) * SEQ * 64; const bf16* Vb = V + (size_t)(b * 16 + h) * SEQ * 64;
            if (F.tid == 0) bitsL[256] = 0u;
            FA_WAITBAR();
            if (F.tid < 256) {
                unsigned bits = 0u;
                if (cb <= 3) bits = (1u << cb) - 1u;
                else {
                    float q[64]; load_row64(Qb + (size_t)(cb * 256 + F.tid) * 64, q);
                    const float* km = KM + (size_t)(b * 16 + h) * 16 * 64;
                    float v1 = -INFINITY, v2 = -INFINITY, v3 = -INFINITY; int i1 = 0, i2 = 0, i3 = 0;
                    for (int n = 0; n < cb; ++n) {
                        float g0 = 0.f, g1 = 0.f;
#pragma unroll
                        for (int d = 0; d < 64; d += 2) { g0 += q[d] * km[n * 64 + d]; g1 += q[d + 1] * km[n * 64 + d + 1]; }
                        const float g = g0 + g1;
                        if (g > v1) { v3 = v2; i3 = i2; v2 = v1; i2 = i1; v1 = g; i1 = n; }
                        else if (g > v2) { v3 = v2; i3 = i2; v2 = g; i2 = n; }
                        else if (g > v3) { v3 = g; i3 = n; }
                    }
                    bits = (1u << i1) | (1u << i2) | (1u << i3);
                }
                bitsL[F.tid] = bits;
                __hip_atomic_fetch_or(&bitsL[256], bits, __ATOMIC_RELAXED, __HIP_MEMORY_SCOPE_WORKGROUP);
            }
            FA_WAITBAR();
            const unsigned mybits = bitsL[wave * 32 + r32];
            const unsigned umask = (unsigned)__builtin_amdgcn_readfirstlane(bitsL[256]) | (1u << cb);
            const int nt = 4 * __builtin_popcount(umask);
            if (wave == 0) { const int blk = lane >> 2; if ((umask >> blk) & 1u) TL[4 * __builtin_popcount(umask & ((1u << blk) - 1u)) + (lane & 3)] = lane; }
            FA_WAITBAR();
            const int t = cb * 256 + wave * 32 + r32;
            const bf16* Qp = Qb + (size_t)t * 64 + hi * 8;
            bf16x8 qr[4];
#pragma unroll
            for (int d0 = 0; d0 < 4; ++d0) qr[d0] = *(const bf16x8*)(Qp + d0 * 16);
            asm volatile("" : "+v"(qr[0]), "+v"(qr[1]), "+v"(qr[2]), "+v"(qr[3]));
            f32x16 o[2]; RowState st; row_init(st);
#pragma unroll
            for (int db = 0; db < 2; ++db)
#pragma unroll
                for (int r = 0; r < 16; ++r) o[db][r] = 0.f;
#define MOBA_STAGE(tile, buf) do { LAS unsigned char* B_ = L + (buf) * 16384; stage_k64(Kb + (size_t)(tile) * 4096, B_, wave, lane); stage_v64(Vb + (size_t)(tile) * 4096, B_ + 8192, wave, lane); } while (0)
            for (int jj = 0; jj < 3 && jj < nt; ++jj) MOBA_STAGE(__builtin_amdgcn_readfirstlane(TL[jj]), jj);
            for (int j = 0; j < nt; ++j) {
                const int ahead = nt - 1 - j;
                FA_RINGBAR2(ahead);
                if (j + 3 < nt) MOBA_STAGE(__builtin_amdgcn_readfirstlane(TL[j + 3]), (j + 3) & 3);
                const int tile = __builtin_amdgcn_readfirstlane(TL[j]), n_cur = tile >> 2, tt = tile & 3;
                const LAS unsigned char* B = L + (j & 3) * 16384;
                {
                    const bool past = n_cur < cb, sel = past ? ((mybits >> n_cur) & 1u) != 0u : true;
                    const int wq = wave >> 1;
                    const bool active = past ? (bool)__any(sel) : (tt <= wq), use_keep = past && !__all(sel), edge = !past && tt == wq;
                    if (active) attn_tile<2>(B, B + 8192, qr, st, o, edge, -1, wave * 32 + r32 - tt * 64, use_keep, sel, lane);
                }
            }
#undef MOBA_STAGE
            store_ot<2>(ATT + (size_t)(b * SEQ + t) * D + h * 64, o, 1.0f / xsum(st.l), hi);
            FA_WAITBAR();
        }
}

__device__ __forceinline__ void moba_attn_fast2(Frame& F, const bf16* Q, const bf16* K, const bf16* V, const float* KM, bf16* ATT) {
    using namespace fa;
    int lane_ = F.lane; asm volatile("" : "+v"(lane_));
    const int lane = lane_, wave = F.wave, r32 = lane & 31, hi = lane >> 5, w4 = wave & 3;
    LAS unsigned char* L = F.lds;
    LAS unsigned* bitsL = (LAS unsigned*)(L + 65536);
    LAS int* TL = (LAS int*)(L + 65536 + 4096);
    for (int slot = F.vcu; slot < 256; slot += F.G)
        for (int i = 0; i < 4; ++i) {
            const int bh = (slot >> 5) * 16 + i * 4 + ((slot >> 3) & 3), pp = (i & 1) ? 7 - (slot & 7) : (slot & 7), cb0 = 2 * pp, cbw = cb0 + (wave >> 2), b = bh >> 4, h = bh & 15;
            const bf16* Qb = Q + (size_t)(b * 16 + h) * SEQ * 64; const bf16* Kb = K + (size_t)(b * 16 + h) * SEQ * 64; const bf16* Vb = V + (size_t)(b * 16 + h) * SEQ * 64;
            LAS float* KML = (LAS float*)(L + 65536 + 8192);
            { const float* km = KM + (size_t)(b * 16 + h) * 16 * 64; KML[F.tid] = km[F.tid]; KML[512 + F.tid] = km[512 + F.tid]; }
            if (F.tid == 0) bitsL[512] = 0u;
            FA_WAITBAR();
            {
                unsigned bits = 0u;
                if (cbw <= 3) bits = (1u << cbw) - 1u;
                else {
                    float q[64]; load_row64(Qb + (size_t)(cb0 * 256 + F.tid) * 64, q);
                    float v1 = -INFINITY, v2 = -INFINITY, v3 = -INFINITY; int i1 = 0, i2 = 0, i3 = 0;
                    for (int n = 0; n < cbw; ++n) {
                        const LAS f32x4* kr = (const LAS f32x4*)(KML + n * 64);
                        float g0 = 0.f, g1 = 0.f;
#pragma unroll
                        for (int d4 = 0; d4 < 16; ++d4) { const f32x4 kv = kr[d4]; g0 += q[4 * d4] * kv[0]; g1 += q[4 * d4 + 1] * kv[1]; g0 += q[4 * d4 + 2] * kv[2]; g1 += q[4 * d4 + 3] * kv[3]; }
                        const float g = g0 + g1;
                        if (g > v1) { v3 = v2; i3 = i2; v2 = v1; i2 = i1; v1 = g; i1 = n; }
                        else if (g > v2) { v3 = v2; i3 = i2; v2 = g; i2 = n; }
                        else if (g > v3) { v3 = g; i3 = n; }
                    }
                    bits = (1u << i1) | (1u << i2) | (1u << i3);
                }
                bitsL[F.tid] = bits;
                unsigned wb = bits;
#pragma unroll
                for (int off = 1; off < 64; off <<= 1) wb |= (unsigned)__shfl_xor((int)wb, off);
                if (lane == 0) __hip_atomic_fetch_or(&bitsL[512], wb, __ATOMIC_RELAXED, __HIP_MEMORY_SCOPE_WORKGROUP);
            }
            FA_WAITBAR();
            const unsigned bitsA = bitsL[wave * 64 + r32], bitsB = bitsL[wave * 64 + 32 + r32];
            const unsigned umask = (unsigned)__builtin_amdgcn_readfirstlane(bitsL[512]) | (3u << cb0);
            const int nt = 4 * __builtin_popcount(umask);
            if (wave == 0) { const int blk = lane >> 2; if ((umask >> blk) & 1u) TL[4 * __builtin_popcount(umask & ((1u << blk) - 1u)) + (lane & 3)] = lane; }
            FA_WAITBAR();
            const int tA = cbw * 256 + w4 * 64 + r32, tB = tA + 32;
            bf16x8 qa[4], qb[4];
#pragma unroll
            for (int d0 = 0; d0 < 4; ++d0) { qa[d0] = *(const bf16x8*)(Qb + (size_t)tA * 64 + hi * 8 + d0 * 16); qb[d0] = *(const bf16x8*)(Qb + (size_t)tB * 64 + hi * 8 + d0 * 16); }
            asm volatile("" : "+v"(qa[0]), "+v"(qa[1]), "+v"(qa[2]), "+v"(qa[3]), "+v"(qb[0]), "+v"(qb[1]), "+v"(qb[2]), "+v"(qb[3]));
            f32x16 oa[2], ob[2]; RowState2 sa, sb; row_init2(sa); row_init2(sb);
#pragma unroll
            for (int db = 0; db < 2; ++db)
#pragma unroll
                for (int r = 0; r < 16; ++r) { oa[db][r] = 0.f; ob[db][r] = 0.f; }
#define MOBA_STAGE(tile, buf) do { LAS unsigned char* B_ = L + (buf) * 16384; stage_k64(Kb + (size_t)(tile) * 4096, B_, wave, lane); stage_v64(Vb + (size_t)(tile) * 4096, B_ + 8192, wave, lane); } while (0)
            for (int jj = 0; jj < 3 && jj < nt; ++jj) MOBA_STAGE(__builtin_amdgcn_readfirstlane(TL[jj]), jj);
            for (int j = 0; j < nt; ++j) {
                const int ahead = nt - 1 - j;
                FA_RINGBAR2(ahead);
                int lane = lane_; asm volatile("" : "+v"(lane));
                const int r32 = lane & 31;
                if (j + 3 < nt) MOBA_STAGE(__builtin_amdgcn_readfirstlane(TL[j + 3]), (j + 3) & 3);
                const int tile = __builtin_amdgcn_readfirstlane(TL[j]), n_cur = tile >> 2, tt = tile & 3;
                const LAS unsigned char* B = L + (j & 3) * 16384;
                const bool past = n_cur < cbw, own = n_cur == cbw;
                const bool selA = past ? ((bitsA >> n_cur) & 1u) != 0u : true, selB = past ? ((bitsB >> n_cur) & 1u) != 0u : true;
                const bool active = past ? (bool)__any(selA || selB) : (own && tt <= w4), edge = own && tt == w4;
                if (active) {
                    bf16x8 pa[4], pb[4];
                    { f32x16 p0, p1, c; const float c1 = selA ? -sa.mref : -INFINITY;
#pragma unroll
                      for (int r = 0; r < 16; ++r) c[r] = c1;
                      scores_c(B, qa, c, p0, p1, lane); softmax_pack<2>(p0, p1, sa, oa, pa, edge, -1, r32, lane); }
                    __builtin_amdgcn_sched_barrier(0);
                    { f32x16 p0, p1, c; const float c1 = selB ? -sb.mref : -INFINITY;
#pragma unroll
                      for (int r = 0; r < 16; ++r) c[r] = c1;
                      scores_c(B, qb, c, p0, p1, lane); softmax_pack<2>(p0, p1, sb, ob, pb, edge, -1, 32 + r32, lane); }
                    __builtin_amdgcn_sched_barrier(0);
                    pv2(B + 8192, pa, pb, oa, ob, lane);
                }
            }
#undef MOBA_STAGE
            store_ot<2>(ATT + (size_t)(b * SEQ + tA) * D + h * 64, oa, 1.0f / xsum(sa.l), hi);
            store_ot<2>(ATT + (size_t)(b * SEQ + tB) * D + h * 64, ob, 1.0f / xsum(sb.l), hi);
            FA_WAITBAR();
        }
}

__device__ __forceinline__ void nsa_attn_fast(Frame& F, const bf16* Q, const bf16* KVC, const bf16* KS, const bf16* VS, const bf16* KW, const bf16* VW, const float* GATE, bf16* ATT) {
    using namespace fa;
    const int wave = F.wave, hd = wave >> 1, qh = wave & 1;
    LAS unsigned char* L = F.lds;
    LAS float* IMP = (LAS float*)(L + 65536);
    LAS unsigned long long* SELL = (LAS unsigned long long*)(L + 65536 + 66560);
    LAS int* TL = (LAS int*)(L + 65536 + 66560 + 512);
    for (int slot = F.vcu; slot < 256; slot += F.G)
        for (int i = 0; i < 8; ++i) {
            int lane_ = F.lane; asm volatile("" : "+v"(lane_));
            const int lane = lane_, r32 = lane & 31, hi = lane >> 5;
            const int bg = (slot >> 5) * 4 + (i >> 1), pq = slot & 31, qblk = (i & 1) ? 63 - pq : pq, b = bg >> 2, g = bg & 3, head = g * 4 + hd;
            const int trel = qh * 32 + r32, t = qblk * 64 + trel;
            const bf16* Qp = Q + ((size_t)(b * 16 + head) * SEQ + t) * 64 + hi * 8;
            bf16x8 qr[4];
#pragma unroll
            for (int d0 = 0; d0 < 4; ++d0) qr[d0] = *(const bf16x8*)(Qp + d0 * 16);
            asm volatile("" : "+v"(qr[0]), "+v"(qr[1]), "+v"(qr[2]), "+v"(qr[3]));
            const float* gt = GATE + (size_t)(b * SEQ + t) * 48 + head * 3; float g0 = gt[0], g1 = gt[1], g2 = gt[2]; asm volatile("" : "+v"(g0), "+v"(g1), "+v"(g2));
            f32x16 ot[2], o[2];
#pragma unroll
            for (int db = 0; db < 2; ++db)
#pragma unroll
                for (int r = 0; r < 16; ++r) { ot[db][r] = 0.f; o[db][r] = 0.f; }
            for (int e = F.tid; e < 4 * 64 * 65; e += 512) IMP[e] = 0.f;
            const bf16* kc = KVC + (size_t)(b * 4 + g) * 256 * 64; const bf16* vc = kc + (size_t)BATCH * 4 * 256 * 64;
            const int nmax = t >= 31 ? (((t - 31) >> 4) < 254 ? ((t - 31) >> 4) : 254) : -1;
            const int numax = ((qblk * 64 + 32) >> 4) < 254 ? ((qblk * 64 + 32) >> 4) : 254;
            const int ntc = (numax >> 6) + 1;
            float m = -INFINITY, l = 0.f;
#define CMP_STAGE(tile, buf) do { LAS unsigned char* B_ = L + (buf) * 16384; stage_k64(kc + (size_t)(tile) * 4096, B_, wave, lane); stage_v64(vc + (size_t)(tile) * 4096, B_ + 8192, wave, lane); } while (0)
            for (int j = 0; j < ntc; ++j) CMP_STAGE(j, j);
            FA_WAITBAR();
            for (int j = 0; j < ntc; ++j) {
                const LAS unsigned char* B = L + j * 16384;
                f32x16 p0, p1; scores(B, qr, p0, p1, lane);
                if (__any(nmax - j * 64 < 63)) edge_mask(p0, p1, -1, nmax - j * 64, hi);
                const float mn = fmaxf(m, rowmax32(p0, p1)), mref = (mn == -INFINITY) ? 0.f : mn;
                float ps = 0.f;
#pragma unroll
                for (int r = 0; r < 16; ++r) ps += ex2(p0[r] - mref) + ex2(p1[r] - mref);
                l = l * ex2(m - mref) + ps; m = mn;
            }
            {
                const float lt = xsum(l), il = lt > 0.f ? 1.0f / lt : 0.f, mref = (m == -INFINITY) ? 0.f : m;
                LAS float* imp = IMP + (size_t)(hd * 64 + trel) * 65; float carry = 0.f;
                for (int j = 0; j < ntc; ++j) {
                    const LAS unsigned char* B = L + j * 16384;
                    f32x16 p0, p1; scores(B, qr, p0, p1, lane);
                    if (__any(nmax - j * 64 < 63)) edge_mask(p0, p1, -1, nmax - j * 64, hi);
#pragma unroll
                    for (int r = 0; r < 16; ++r) { p0[r] = ex2(p0[r] - mref) * il; p1[r] = ex2(p1[r] - mref) * il; }
                    float q0[4], q1[4];
#pragma unroll
                    for (int a = 0; a < 4; ++a) {
                        auto r0 = __builtin_amdgcn_permlane32_swap(__float_as_uint(p0[4 * a + 3]), __float_as_uint(p0[4 * a + 3]), false, false);
                        auto r1 = __builtin_amdgcn_permlane32_swap(__float_as_uint(p1[4 * a + 3]), __float_as_uint(p1[4 * a + 3]), false, false);
                        q0[a] = __uint_as_float(hi ? r0[0] : r0[1]); q1[a] = __uint_as_float(hi ? r1[0] : r1[1]);
                    }
#pragma unroll
                    for (int a = 0; a < 4; ++a) {
                        const float cin0 = hi ? q0[a] : (a ? q0[a > 0 ? a - 1 : 0] : carry), cin1 = hi ? q1[a] : (a ? q1[a > 0 ? a - 1 : 0] : q0[3]);
                        imp[16 * j + 2 * a + hi] = ((p0[4 * a] + p0[4 * a + 1]) + (p0[4 * a + 2] + p0[4 * a + 3])) + cin0;
                        imp[16 * j + 8 + 2 * a + hi] = ((p1[4 * a] + p1[4 * a + 1]) + (p1[4 * a + 2] + p1[4 * a + 3])) + cin1;
                    }
                    carry = q1[3];
                    bf16x8 pw[4]; pack_p(p0, p1, pw);
                    pv<2>(B + 8192, pw, o, lane);
                }
#pragma unroll
                for (int db = 0; db < 2; ++db)
#pragma unroll
                    for (int r = 0; r < 16; ++r) { ot[db][r] = g0 * o[db][r]; o[db][r] = 0.f; }
            }
#undef CMP_STAGE
            FA_WAITBAR();
#pragma unroll 1
            for (int rr = 0; rr < 8; ++rr) {
                const int row = wave * 8 + rr;
                bool sel;
                if (qblk < 16) sel = lane <= qblk;
                else {
                    const float v = (IMP[(size_t)(0 * 64 + row) * 65 + lane] + IMP[(size_t)(1 * 64 + row) * 65 + lane]) + (IMP[(size_t)(2 * 64 + row) * 65 + lane] + IMP[(size_t)(3 * 64 + row) * 65 + lane]);
                    asm volatile("" ::: "memory");
                    IMP[(size_t)row * 65 + lane] = v;
                    asm volatile("s_waitcnt lgkmcnt(0)" ::: "memory");
                    const bool cand = lane >= 1 && lane <= qblk - 2;
                    int rank = 0;
                    for (int k = 1; k <= qblk - 2; ++k) { const float vk = IMP[(size_t)row * 65 + k]; rank += (vk > v || (vk == v && k < lane)) ? 1 : 0; }
                    sel = lane == 0 || lane == qblk || lane == qblk - 1 || (cand && rank < 13);
                }
                const unsigned long long mk = __ballot(sel);
                if (lane == 0) SELL[row] = mk;
            }
            FA_WAITBAR();
            const unsigned long long mysel = SELL[trel];
            unsigned long long un = SELL[lane];
#pragma unroll
            for (int off = 1; off < 64; off <<= 1) { const unsigned lo_ = __shfl_xor((unsigned)un, off), hi_ = __shfl_xor((unsigned)(un >> 32), off); un |= ((unsigned long long)hi_ << 32) | lo_; }
            const unsigned long long umask = ((unsigned long long)(unsigned)__builtin_amdgcn_readfirstlane((unsigned)(un >> 32)) << 32) | (unsigned)__builtin_amdgcn_readfirstlane((unsigned)un);
            const int nts = __builtin_popcountll(umask);
            if (wave == 0) { if ((umask >> lane) & 1ull) TL[__builtin_popcountll(umask & ((1ull << lane) - 1ull))] = lane; }
            FA_WAITBAR();
            {
                const bf16* kb = KS + (size_t)(b * 4 + g) * SEQ * 64; const bf16* vb = VS + (size_t)(b * 4 + g) * SEQ * 64;
#define SEL_STAGE(tile, buf) do { LAS unsigned char* B_ = L + (buf) * 16384; stage_k64(kb + (size_t)(tile) * 4096, B_, wave, lane); stage_v64(vb + (size_t)(tile) * 4096, B_ + 8192, wave, lane); } while (0)
                RowState st; row_init(st);
                for (int jj = 0; jj < 3 && jj < nts; ++jj) SEL_STAGE(__builtin_amdgcn_readfirstlane(TL[jj]), jj);
                for (int j = 0; j < nts; ++j) {
                    const int ahead = nts - 1 - j;
                    FA_RINGBAR2(ahead);
                    if (j + 3 < nts) SEL_STAGE(__builtin_amdgcn_readfirstlane(TL[j + 3]), (j + 3) & 3);
                    const int j_cur = __builtin_amdgcn_readfirstlane(TL[j]);
                    const LAS unsigned char* B = L + (j & 3) * 16384;
                    const bool sel = (mysel >> j_cur) & 1ull;
                    {
                        const bool diag = j_cur == qblk, active = diag || __any(sel), use_keep = !__all(sel);
                        if (active) attn_tile<2>(B, B + 8192, qr, st, o, diag, -1, trel, use_keep, sel, lane);
                    }
                }
#undef SEL_STAGE
                const float lt = xsum(st.l), w1 = lt > 0.f ? g1 / lt : 0.f;
#pragma unroll
                for (int db = 0; db < 2; ++db)
#pragma unroll
                    for (int r = 0; r < 16; ++r) { ot[db][r] += w1 * o[db][r]; o[db][r] = 0.f; }
            }
            FA_WAITBAR();
            {
                const bf16* kb = KW + (size_t)(b * 4 + g) * SEQ * 64; const bf16* vb = VW + (size_t)(b * 4 + g) * SEQ * 64;
#define WIN_STAGE(tile, buf) do { LAS unsigned char* B_ = L + (buf) * 16384; stage_k64(kb + (size_t)(tile) * 4096, B_, wave, lane); stage_v64(vb + (size_t)(tile) * 4096, B_ + 8192, wave, lane); } while (0)
                RowState st; row_init(st);
                const int jlo = qblk >= 8 ? qblk - 8 : 0;
                const int ntw = qblk - jlo + 1;
                for (int jj = 0; jj < 3 && jj < ntw; ++jj) WIN_STAGE(jlo + jj, jj);
                for (int jw = 0; jw < ntw; ++jw) {
                    const int ahead = ntw - 1 - jw, j = jlo + jw;
                    FA_RINGBAR2(ahead);
                    if (jw + 3 < ntw) WIN_STAGE(j + 3, (jw + 3) & 3);
                    const LAS unsigned char* B = L + (jw & 3) * 16384;
                    attn_tile<2>(B, B + 8192, qr, st, o, j == qblk || j == qblk - 8, j == qblk - 8 ? trel : -1, j == qblk ? trel : 63, false, true, lane);
                }
#undef WIN_STAGE
                const float lt = xsum(st.l), w2 = lt > 0.f ? g2 / lt : 0.f;
#pragma unroll
                for (int db = 0; db < 2; ++db)
#pragma unroll
                    for (int r = 0; r < 16; ++r) ot[db][r] += w2 * o[db][r];
            }
            store_ot<2>(ATT + (size_t)(b * SEQ + t) * D + head * 64, ot, 1.0f, hi);
            FA_WAITBAR();
        }
}

constexpr unsigned I8_INPROJ_MASK = 0xFu;
constexpr unsigned F8_DOWN_MASK = 0xF8u;
__device__ __forceinline__ void weights_absmax(Frame& F) {
    LAS float* red = (LAS float*)F.lds;
    for (int item = blockIdx.x; item < 8 * 22 + 4 * 12; item += F.G) {
        const float* W; const float* g; int N, cg, ffn; float* SW; float* SWI;
        if (item < 8 * 22) { const int i = item / 22; cg = item % 22; ffn = 1; N = 2 * DFF; W = F.in[2] + (size_t)i * D * 2 * DFF; g = F.in[1] + (size_t)((i >> 1) * 6 + (i & 1) * 4) * D;
            SW = (float*)(F.ws + TAB_SW) + i * (2 * DFF); SWI = (float*)(F.ws + TAB_SWI) + i * (2 * DFF); }
        else { const int L = (item - 8 * 22) / 12; cg = (item - 8 * 22) % 12; ffn = 0; g = F.in[1] + (size_t)(L * 6 + 2) * D;
            if (L == 1) { W = F.in[8]; N = 3072; } else if (L == 2) { W = F.in[10]; N = NSA_IN; } else { W = F.in[4] + (size_t)(L / 3) * D * 3072; N = 3072; }
            SW = (float*)(F.ws + TAB_SW2) + L * 3072; SWI = (float*)(F.ws + TAB_SWI2) + L * 3072; }
        const int k0 = F.wave * 128, c4 = cg * 256 + 4 * F.lane;
        f32x4 m = {0.f, 0.f, 0.f, 0.f};
        if (c4 < N) {
            const float* Wp = W + (size_t)k0 * N + c4;
#pragma unroll 16
            for (int k = 0; k < 128; ++k) { const f32x4 v = *(const f32x4*)(Wp + (size_t)k * N) * g[k0 + k];
                m[0] = fmaxf(m[0], fabsf(v[0])); m[1] = fmaxf(m[1], fabsf(v[1])); m[2] = fmaxf(m[2], fabsf(v[2])); m[3] = fmaxf(m[3], fabsf(v[3])); }
        }
        *(LAS f32x4*)(red + F.wave * 256 + 4 * F.lane) = m;
        __syncthreads();
        if (F.tid < 256) {
            float a = red[F.tid];
#pragma unroll
            for (int w = 1; w < 8; ++w) a = fmaxf(a, red[w * 256 + F.tid]);
            const int n = cg * 256 + F.tid; int r = n;
            if (ffn) { const int up = n >= DFF ? 1 : 0, j = n - up * DFF; r = 256 * (j >> 7) + 128 * up + (j & 127); }
            SW[r] = a * (1.0f / 127.0f); SWI[r] = a > 0.f ? 127.0f / a : 0.f;
        }
        __syncthreads();
    }
    for (int i = 0; i < 8; ++i) {
        if (!((F8_DOWN_MASK >> i) & 1u)) continue;
        const f32x4* W4 = (const f32x4*)(F.in[3] + (size_t)i * DFF * D);
        float m = 0.f;
        for (int idx = blockIdx.x * 512 + F.tid; idx < DFF * D / 4; idx += F.G * 512) { const f32x4 v = W4[idx]; m = fmaxf(fmaxf(m, fmaxf(fabsf(v[0]), fabsf(v[1]))), fmaxf(fabsf(v[2]), fabsf(v[3]))); }
        m = wave_max(m);
        if (F.lane == 0) red[F.wave] = m;
        __syncthreads();
        if (F.tid == 0) { float a = red[0];
#pragma unroll
            for (int w = 1; w < 8; ++w) a = fmaxf(a, red[w]);
            __hip_atomic_fetch_max((unsigned*)(F.ws + WS_CTL) + CW_WOMAX + i, __float_as_uint(a), __ATOMIC_RELAXED, __HIP_MEMORY_SCOPE_AGENT); }
        __syncthreads();
    }
}
__device__ __forceinline__ void prologue(Frame& F) {
    unsigned char* ws = F.ws;
    int cbase = 0;
    for (int i = 0; i < 8; ++i) conv_matrix(F, cbase, F.in[2] + (size_t)i * D * 2 * DFF, D, 2 * DFF, 2 * DFF, (bf16*)(ws + W_FFN_IN + i * FFN_IN_BYTES), 1, F.in[1] + (size_t)((i >> 1) * 6 + (i & 1) * 4) * D, (const float*)(ws + TAB_SWI) + i * (2 * DFF));
    for (int i = 0; i < 8; ++i) conv_matrix(F, cbase, F.in[3] + (size_t)i * DFF * D, DFF, D, D, (bf16*)(ws + W_FFN_OUT + i * FFN_OUT_BYTES), 0, nullptr, nullptr, ((F8_DOWN_MASK >> i) & 1u) ? (const float*)(ws + WS_CTL) + CW_WOMAX + i : nullptr);
    for (int i = 0; i < 2; ++i) conv_matrix(F, cbase, F.in[4] + (size_t)i * D * 3072, D, 3072, 3072, (bf16*)(ws + W_DIFF_IN + i * 6 * MiB), 0, F.in[1] + (size_t)((i * 3) * 6 + 2) * D, ((I8_INPROJ_MASK >> (3 * i)) & 1u) ? (const float*)(ws + TAB_SWI2) + (3 * i) * 3072 : nullptr);
    for (int i = 0; i < 2; ++i) conv_matrix(F, cbase, F.in[5] + (size_t)i * D * D, D, D, D, (bf16*)(ws + W_DIFF_OUT + i * 2 * MiB), 0);
    conv_matrix(F, cbase, F.in[8], D, 3072, 3072, (bf16*)(ws + W_MOBA_IN), 0, F.in[1] + (size_t)(1 * 6 + 2) * D, ((I8_INPROJ_MASK >> 1) & 1u) ? (const float*)(ws + TAB_SWI2) + 1 * 3072 : nullptr);
    conv_matrix(F, cbase, F.in[9], D, D, D, (bf16*)(ws + W_MOBA_OUT), 0);
    conv_matrix(F, cbase, F.in[10], D, NSA_IN, NSA_IN_PAD, (bf16*)(ws + W_NSA_IN), 0, F.in[1] + (size_t)(2 * 6 + 2) * D, ((I8_INPROJ_MASK >> 2) & 1u) ? (const float*)(ws + TAB_SWI2) + 2 * 3072 : nullptr);
    conv_matrix(F, cbase, F.in[11], D, D, D, (bf16*)(ws + W_NSA_OUT), 0);
    for (int i = 0; i < 2; ++i) conv_matrix(F, cbase, F.in[13] + (size_t)i * 2048 * 256, 2048, 256, 256, (bf16*)(ws + W_CMP1) + (size_t)i * 256 * 2048, 0);
    for (int i = 0; i < 2; ++i) conv_matrix(F, cbase, F.in[14] + (size_t)i * 256 * 64, 256, 64, 256, (bf16*)(ws + W_CMP2) + (size_t)i * 256 * 256, 0);
    {
        const double invf[8] = {1.0, 0.19392274474868576, 0.03760603093086393, 0.007292664737217109, 0.001414213562373095, 0.0002742481756762073, 5.318295896944988e-05, 1.031338537721246e-05};
        float* cs = (float*)(ws + TAB_COS); float* sn = (float*)(ws + TAB_SIN);
        for (int e = blockIdx.x * 512 + F.tid; e < SEQ * 8; e += F.G * 512) {
            const int t = e >> 3, i = e & 7;
            double f = invf[0];
#pragma unroll
            for (int k = 1; k < 8; ++k) f = (i == k) ? invf[k] : f;
            const double ang = (double)t * f, TWO_PI = 6.283185307179586476925286766559;
            const double kk = __builtin_rint(ang / TWO_PI), r = ang - kk * TWO_PI, z = r * r;
            double ts = r, ss = r, tc = 1.0, sc = 1.0;
#pragma unroll
            for (int k = 1; k <= 14; ++k) { ts *= -z / (double)((2 * k) * (2 * k + 1)); ss += ts; tc *= -z / (double)((2 * k - 1) * (2 * k)); sc += tc; }
            cs[e] = (float)sc; sn[e] = (float)ss;
        }
    }
    for (int task = blockIdx.x; task < 256; task += F.G) {
        const int kv = task >> 7, cg = (task >> 5) & 3, kc = task & 31, k0 = kc * 64 + F.wave * 8;
        const float* pe = F.in[12] + (size_t)kv * 2048 + k0; const float* w1 = F.in[13] + (size_t)kv * 2048 * 256 + (size_t)k0 * 256 + cg * 64 + F.lane;
        float a = 0.f;
#pragma unroll
        for (int k = 0; k < 8; ++k) a += pe[k] * w1[(size_t)k * 256];
        LAS float* red = (LAS float*)(F.lds + 131072);
        red[F.wave * 64 + F.lane] = a;
        __syncthreads();
        if (F.wave == 0) { float s = 0.f;
#pragma unroll
            for (int w = 0; w < 8; ++w) s += red[w * 64 + F.lane];
            ((float*)(ws + TAB_CBP))[kc * 512 + kv * 256 + cg * 64 + F.lane] = s; }
        __syncthreads();
    }
    if (blockIdx.x == 0 && F.wave == 0) {
        for (int j = 0; j < 2; ++j) {
            const float* lm = F.in[6] + j * 256;
            const float s1 = wave_sum(lm[F.lane] * lm[64 + F.lane]), s2 = wave_sum(lm[128 + F.lane] * lm[192 + F.lane]);
            const float li = j == 0 ? 0.2f : 0.5560582041556406f;
            if (F.lane == 0) ((float*)(ws + TAB_LAM))[j] = ex2(s1 * 1.4426950408889634f) - ex2(s2 * 1.4426950408889634f) + li;
        }
    }
    rows_phase(F, F.in[0], nullptr, 0.f, nullptr, (bf16*)(ws + WS_XN), (float*)(ws + TAB_RSTD), nullptr);
}


template <int HS>
__device__ __forceinline__ void ffn_half(Frame& F, const XcdBarrier& bar) {
    constexpr int l = HS >> 1, idx = HS & 1;
    constexpr bool F8D = ((F8_DOWN_MASK >> HS) & 1u) != 0;
    unsigned char* ws = F.ws;
    bf16* XN = (bf16*)(ws + WS_XN); bf16* Y = (bf16*)(ws + WS_Y); bf16* U = (bf16*)(ws + WS_U);
    {
        pg8::Gemm g{(const bf16*)(ws + WS_H8), (const bf16*)(ws + W_FFN_IN + (size_t)HS * FFN_IN_BYTES), D / 2, D / 2}; pg8::StaticOrder S; S.init(NTOK, 2 * DFF, F.G, (int)blockIdx.x);
        pg8::EpiSwiGLU<true, F8D> E{U, DFF, (const float*)(ws + TAB_RS8), (const float*)(ws + TAB_SW) + HS * (2 * DFF)};
        pg8::gemm_phase<pg8::EpiSwiGLU<true, F8D>, pg8::StaticOrder, true, true, 1>(F.lds, g, S, E, F.tid);
    }
    phase_sync(F, bar);
    {
        pg8::StaticOrder S; S.init(NTOK, D, F.G, (int)blockIdx.x);
        if constexpr (F8D) {
            float* oscp = (float*)(ws + WS_CTL) + CW_WOMAX + 8 + HS;
            if (F.tid == 0) *oscp = ((const float*)(ws + WS_CTL))[CW_WOMAX + HS] * (1.0f / (W8_TOP * pg8::U8_SCALE));
            pg8::Gemm g{U, (const bf16*)(ws + W_FFN_OUT + (size_t)HS * FFN_OUT_BYTES), DFF / 2, DFF / 2};
            pg8::EpiPlain E{Y, D, oscp};
            pg8::gemm_phase<pg8::EpiPlain, pg8::StaticOrder, true, true, 2>(F.lds, g, S, E, F.tid);
        } else {
            pg8::Gemm g{U, (const bf16*)(ws + W_FFN_OUT + (size_t)HS * FFN_OUT_BYTES), DFF, DFF};
            pg8::EpiPlain E{Y, D, nullptr};
            pg8::gemm_phase<pg8::EpiPlain, pg8::StaticOrder, true, true>(F.lds, g, S, E, F.tid);
        }
    }
    phase_sync(F, bar);
    {
        const float* ng = F.in[1] + (size_t)l * 6 * D;
        rows_phase(F, nullptr, Y, 0.5f, ng + (idx ? 5 : 1) * D, XN, (float*)(ws + TAB_RSTD), HS == 2 * DEPTH - 1 ? F.out : nullptr);
    }
    phase_sync(F, bar);
}

template <int L>
__device__ __forceinline__ void mixer(Frame& F, const XcdBarrier& bar) {
    constexpr int kind = L % 3, j = L / 3;
    unsigned char* ws = F.ws;
    bf16* XN = (bf16*)(ws + WS_XN); bf16* Y = (bf16*)(ws + WS_Y); bf16* ATT = (bf16*)(ws + WS_ATT); bf16* U = (bf16*)(ws + WS_U);
    const float* cs = (const float*)(ws + TAB_COS); const float* sn = (const float*)(ws + TAB_SIN);
    if constexpr (kind == 2) {
        if (blockIdx.x == 0) { float s = 0.f; const float* cp = (const float*)(ws + TAB_CBP) + F.tid;
#pragma unroll
            for (int i = 0; i < 32; ++i) s += cp[i * 512];
            ((float*)(ws + TAB_CBIAS))[F.tid] = s; }
    }
    {
        const bf16* Win = (const bf16*)(ws + (kind == 0 ? W_DIFF_IN + (size_t)j * 6 * MiB : (kind == 1 ? W_MOBA_IN : W_NSA_IN)));
        constexpr bool I8 = ((I8_INPROJ_MASK >> L) & 1u) != 0;
        pg8::StaticOrder S; S.init(NTOK, kind == 2 ? (I8 ? 2560 : NSA_IN_PAD) : 3072, F.G, (int)blockIdx.x);
        if constexpr (I8) {
            pg8::Gemm g{(const bf16*)(ws + WS_H8), Win, D / 2, D / 2};
            pg8::EpiHeads<kind, true> E{U, (float*)(ws + WS_GATE), cs, sn, (const float*)(ws + TAB_RS8), (const float*)(ws + TAB_SW2) + L * 3072};
            pg8::gemm_phase<pg8::EpiHeads<kind, true>, pg8::StaticOrder, true, true, 1>(F.lds, g, S, E, F.tid);
        } else {
            pg8::Gemm g{XN, Win, D, D};
            pg8::EpiHeads<kind, false> E{U, (float*)(ws + WS_GATE), cs, sn, (const float*)(ws + TAB_RSTD), nullptr};
            pg8::gemm_phase<pg8::EpiHeads<kind, false>, pg8::StaticOrder, true, true>(F.lds, g, S, E, F.tid);
        }
    }
    phase_sync(F, bar);
    const bf16* Q = U; const bf16* K = U + (size_t)NTOK * 1024; const bf16* V = U + (size_t)2 * NTOK * 1024;
    if constexpr (kind == 0) {
        constexpr float li = L == 0 ? 0.2f : 0.5560582041556406f;
        DIFF_ATTN(F, Q, K, V, ATT, ((const float*)(ws + TAB_LAM))[j], li, F.in[7] + j * 128);
    } else if constexpr (kind == 1) {
        moba_kmean(F, K, (float*)(ws + TAB_KMEAN));
        phase_sync(F, bar);
        MOBA_ATTN(F, Q, K, V, (const float*)(ws + TAB_KMEAN), ATT);
    } else {
        const bf16* KC = U + (size_t)NTOK * 1024;
        const size_t KVT = (size_t)NTOK * 256;
        {
            pg8::Gemm g{KC, (const bf16*)(ws + W_CMP1), 1024, 2048}; pg8::CmpOrder S{F.G, (int)blockIdx.x};
            pg8::EpiCmp1 E{(bf16*)(ws + WS_CH), (const float*)(ws + TAB_CBIAS)};
            pg8::gemm_phase<pg8::EpiCmp1, pg8::CmpOrder, true, true>(F.lds, g, S, E, F.tid);
        }
        if constexpr (((I8_INPROJ_MASK >> L) & 1u) != 0) {
            const int off = F.G > 128 ? 64 : 0;
            pg8::Gemm g{(const bf16*)(ws + WS_H8), (const bf16*)(ws + W_NSA_IN), D / 2, D / 2}; pg8::TileOrder S{F.G - off, (int)blockIdx.x - off, 10};
            pg8::EpiHeads<2, true> E{U, (float*)(ws + WS_GATE), cs, sn, (const float*)(ws + TAB_RS8), (const float*)(ws + TAB_SW2) + L * 3072};
            pg8::gemm_phase<pg8::EpiHeads<2, true>, pg8::TileOrder, true, true, 1>(F.lds, g, S, E, F.tid);
        }
        phase_sync(F, bar);
        {
            pg8::Gemm g{(const bf16*)(ws + WS_CH), (const bf16*)(ws + W_CMP2), 256, 256}; pg8::CmpOrder S{F.G, (int)blockIdx.x};
            pg8::EpiCmp2 E{(bf16*)(ws + WS_KVC)};
            pg8::gemm_phase<pg8::EpiCmp2, pg8::CmpOrder, true, true>(F.lds, g, S, E, F.tid);
        }
        phase_sync(F, bar);
#if NSA_FAST
        nsa_attn_fast(F, Q, (const bf16*)(ws + WS_KVC), KC + 2 * KVT, KC + 3 * KVT, KC + 4 * KVT, KC + 5 * KVT, (const float*)(ws + WS_GATE), ATT);
#else
        nsa_select_slow(F, Q, (const bf16*)(ws + WS_KVC), (unsigned long long*)(ws + WS_SEL));
        phase_sync(F, bar);
        nsa_attn_slow(F, Q, (const bf16*)(ws + WS_KVC), KC + 2 * KVT, KC + 3 * KVT, KC + 4 * KVT, KC + 5 * KVT, (const float*)(ws + WS_GATE), (const unsigned long long*)(ws + WS_SEL), ATT);
#endif
    }
    phase_sync(F, bar);
    {
        const bf16* Wout = (const bf16*)(ws + (kind == 0 ? W_DIFF_OUT + (size_t)j * 2 * MiB : (kind == 1 ? W_MOBA_OUT : W_NSA_OUT)));
        pg8::Gemm g{ATT, Wout, D, D}; pg8::StaticOrder S; S.init(NTOK, D, F.G, (int)blockIdx.x);
        pg8::EpiPlain E{Y, D, nullptr};
        pg8::gemm_phase<pg8::EpiPlain, pg8::StaticOrder, true, true>(F.lds, g, S, E, F.tid);
    }
    phase_sync(F, bar);
    {
        const float* ng = F.in[1] + (size_t)L * 6 * D;
        rows_phase(F, nullptr, Y, 1.0f, ng + 3 * D, XN, (float*)(ws + TAB_RSTD), nullptr);
    }
    phase_sync(F, bar);
}

__global__ void __launch_bounds__(NWAVES * 64, 2) fwd_kernel(Args args) {
    extern __shared__ __attribute__((aligned(16))) unsigned char lds[];
    Frame F;
    F.lds = (LAS unsigned char*)lds;
    F.MISC = (volatile LAS unsigned*)(F.lds + LDSCTL_OFF);
    F.tid = threadIdx.x; F.lane = F.tid & 63; F.wave = __builtin_amdgcn_readfirstlane(F.tid >> 6); F.G = gridDim.x; { const int bx = blockIdx.x; F.vcu = (F.G % 8 == 0) ? (bx % 8) * (F.G / 8) + bx / 8 : bx; }
    F.in.a = &args;
    F.out = args.out; F.ws = args.ws;
    for (int u = F.tid; u < (LDS_BYTES - LDSCTL_OFF) / 4; u += NWAVES * 64) ((LAS unsigned*)(F.lds + LDSCTL_OFF))[u] = 0u;
    __syncthreads();
    const XcdBarrier bar = xcd_barrier_post((unsigned*)(args.ws + WS_CTL) + CW_BAR, F.MISC + 8);

    weights_absmax(F);
    phase_sync(F, bar);
    prologue(F);
    phase_sync(F, bar);
    ffn_half<0>(F, bar); mixer<0>(F, bar); ffn_half<1>(F, bar);
    ffn_half<2>(F, bar); mixer<1>(F, bar); ffn_half<3>(F, bar);
    ffn_half<4>(F, bar); mixer<2>(F, bar); ffn_half<5>(F, bar);
    ffn_half<6>(F, bar); mixer<3>(F, bar); ffn_half<7>(F, bar);
}

extern "C" void kernel_launch(void* const* d_in, const int* in_sizes, int n_in, void* d_out, int out_size, void* d_ws, size_t ws_size, hipStream_t stream) {
    static int grid = 0;
    if (grid == 0) {
        if (n_in != 15 || in_sizes[0] != NTOK * D || out_size != NTOK * D || ws_size < WS_END) { fprintf(stderr, "kernel_launch: unexpected shapes (n_in %d, in0 %d, out %d, ws %zu < %zu)\n", n_in, n_in > 0 ? in_sizes[0] : -1, out_size, ws_size, (size_t)WS_END); grid = -1; return; }
        int dev = 0, cus = 0, per_cu = 0;
        if (hipGetDevice(&dev) != hipSuccess || hipDeviceGetAttribute(&cus, hipDeviceAttributeMultiprocessorCount, dev) != hipSuccess) { grid = -1; return; }
        if (hipFuncSetAttribute((const void*)fwd_kernel, hipFuncAttributeMaxDynamicSharedMemorySize, LDS_BYTES) != hipSuccess) { fprintf(stderr, "kernel_launch: hipFuncSetAttribute failed\n"); grid = -1; return; }
        if (hipOccupancyMaxActiveBlocksPerMultiprocessor(&per_cu, (const void*)fwd_kernel, NWAVES * 64, LDS_BYTES) != hipSuccess || per_cu < 1) fprintf(stderr, "kernel_launch: occupancy query reports %d\n", per_cu);
        (void)hipGetLastError();
        grid = cus;
    }
    if (grid < 0) return;
    if (hipMemsetAsync((char*)d_ws + WS_CTL, 0, CTL_ZERO_BYTES, stream) != hipSuccess) return;
    Args a{};
    for (int i = 0; i < 15; ++i) a.in[i] = (const float*)d_in[i];
    a.out = (float*)d_out; a.ws = (unsigned char*)d_ws;
    hipLaunchKernelGGL(fwd_kernel, dim3(grid), dim3(NWAVES * 64), LDS_BYTES, stream, a);
}
```
